# Optimizing an MI355X kernel written in HIP

```python
import math
import jax, jax.numpy as jnp
from jax import lax
import numpy as np

D_MODEL = 2048
BATCH = 4
SEQ = 4096
DEPTH = 2

NORM_EPS = 1e-6
BLOCK = 128

LRU_WIDTH = 1024
LRU_BLOCKS = 8
LRU_BLOCK_DIM = LRU_WIDTH // LRU_BLOCKS
CONV_WIDTH = 4
LRU_C = 8.0
SWA_Q_HEADS = 16
SWA_KV_HEADS = 2
SWA_HEAD_DIM = 64
SWA_GROUP = SWA_Q_HEADS // SWA_KV_HEADS
SWA_WIDTH = SWA_Q_HEADS * SWA_HEAD_DIM
SWA_KV_WIDTH = SWA_KV_HEADS * SWA_HEAD_DIM
WINDOW = 128
EVEN_SPLITS = [LRU_WIDTH, LRU_WIDTH, SWA_WIDTH, SWA_KV_WIDTH, SWA_KV_WIDTH, SWA_WIDTH]
EVEN_IN = sum(EVEN_SPLITS)
EVEN_MIX = LRU_WIDTH + SWA_WIDTH

MLA_HEADS = 8
MLA_Q_RANK = 768
MLA_KV_RANK = 512
MLA_NOPE = 128
MLA_ROPE = 64
MLA_V = 128
MLA_WIDTH = MLA_HEADS * MLA_V
ROPE_THETA = 10000.0
DIFF_HEADS = 8
DIFF_QK = 64
DIFF_V = 2 * DIFF_QK
DIFF_QK_WIDTH = DIFF_HEADS * 2 * DIFF_QK
DIFF_WIDTH = DIFF_HEADS * DIFF_V
DIFF_LAYER_IDX = 1
DIFF_LAMBDA_INIT = 0.8 - 0.6 * math.exp(-0.3 * DIFF_LAYER_IDX)
ODD_SPLITS = [MLA_Q_RANK, MLA_KV_RANK, MLA_ROPE, MLA_WIDTH,
              DIFF_QK_WIDTH, DIFF_QK_WIDTH, DIFF_WIDTH, DIFF_WIDTH]
ODD_IN = sum(ODD_SPLITS)
ODD_MIX = MLA_WIDTH + DIFF_WIDTH

kernel_name = "hybrid_rglru_swa_mla_diff_trunk"


def rmsnorm(x, g):
    xf = x.astype(jnp.float32)
    y = xf * lax.rsqrt(jnp.mean(xf * xf, axis=-1, keepdims=True) + NORM_EPS)
    return (y * g.astype(jnp.float32)).astype(x.dtype)


def split_cols(z, sizes):
    idx = [int(i) for i in np.cumsum(sizes)[:-1]]
    return jnp.split(z, idx, axis=-1)


def rope(x, pos):
    half = x.shape[-1] // 2
    freq = ROPE_THETA ** (-jnp.arange(half, dtype=jnp.float32) / half)
    ang = pos.astype(jnp.float32)[:, None] * freq[None, :]
    cos = jnp.cos(ang)[:, None, :]
    sin = jnp.sin(ang)[:, None, :]
    xf = x.astype(jnp.float32)
    x1, x2 = xf[..., :half], xf[..., half:]
    return jnp.concatenate([x1 * cos - x2 * sin, x1 * sin + x2 * cos], axis=-1).astype(x.dtype)


def causal_depthwise_conv(x, w, b):
    y = lax.conv_general_dilated(
        x, w[:, None, :].astype(x.dtype), window_strides=(1,),
        padding=[(CONV_WIDTH - 1, 0)], dimension_numbers=("NWC", "WIO", "NWC"),
        feature_group_count=x.shape[-1])
    return y + b


def rg_lru(x, gx_w, gx_b, ga_w, ga_b, lru_lambda):
    B, S, _ = x.shape
    xb = x.reshape(B, S, LRU_BLOCKS, LRU_BLOCK_DIM)
    gate_i = jax.nn.sigmoid(jnp.einsum("bsnd,nde->bsne", xb, gx_w) + gx_b).reshape(B, S, LRU_WIDTH)
    gate_r = jax.nn.sigmoid(jnp.einsum("bsnd,nde->bsne", xb, ga_w) + ga_b).reshape(B, S, LRU_WIDTH)
    log_a = -LRU_C * jax.nn.softplus(-lru_lambda.astype(jnp.float32)) * gate_r.astype(jnp.float32)
    a = jnp.exp(log_a)
    mult = jnp.sqrt(-jnp.expm1(2.0 * log_a))
    u = mult * gate_i.astype(jnp.float32) * x.astype(jnp.float32)

    def combine(c1, c2):
        a1, b1 = c1
        a2, b2 = c2
        return a1 * a2, a2 * b1 + b2

    _, h = lax.associative_scan(combine, (a, u), axis=1)
    return h.astype(x.dtype)


def sliding_window_gqa_sinks(q, k, v, sinks):
    B, S = q.shape[:2]
    nb = S // BLOCK
    qb = q.reshape(B, nb, BLOCK, SWA_KV_HEADS, SWA_GROUP, SWA_HEAD_DIM)

    def band(t):
        tp = jnp.pad(t, ((0, 0), (BLOCK, 0), (0, 0), (0, 0)))
        cur = tp[:, BLOCK:].reshape(B, nb, BLOCK, SWA_KV_HEADS, SWA_HEAD_DIM)
        prev = tp[:, :S].reshape(B, nb, BLOCK, SWA_KV_HEADS, SWA_HEAD_DIM)
        return jnp.concatenate([prev, cur], axis=2)

    kb, vb = band(k), band(v)
    s = jnp.einsum("bnqhgd,bnkhd->bnhgqk", qb, kb).astype(jnp.float32) * (SWA_HEAD_DIM ** -0.5)
    n = jnp.arange(nb)[:, None, None]
    qi = jnp.arange(BLOCK)[None, :, None]
    ki = jnp.arange(2 * BLOCK)[None, None, :]
    rel = qi + BLOCK - ki
    kpos = n * BLOCK - BLOCK + ki
    mask = (rel >= 0) & (rel < WINDOW) & (kpos >= 0)
    s = jnp.where(mask[None, :, None, None], s, -jnp.inf)
    sink = sinks.astype(jnp.float32).reshape(1, 1, SWA_KV_HEADS, SWA_GROUP, 1, 1)
    m = jnp.maximum(jnp.max(s, axis=-1, keepdims=True), sink)
    p = jnp.exp(s - m)
    p = p / (jnp.sum(p, axis=-1, keepdims=True) + jnp.exp(sink - m))
    o = jnp.einsum("bnhgqk,bnkhd->bnqhgd", p.astype(vb.dtype), vb)
    return o.reshape(B, S, SWA_WIDTH)


def sweep_query_blocks(block_fn, q):
    B, S = q.shape[:2]
    nb = S // BLOCK
    qb = jnp.moveaxis(q.reshape((B, nb, BLOCK) + q.shape[2:]), 1, 0)

    def body(args):
        qblk, n = args
        return block_fn(qblk, n * BLOCK + jnp.arange(BLOCK))

    o = lax.map(body, (qb, jnp.arange(nb)))
    o = jnp.moveaxis(o, 0, 1)
    return o.reshape((B, S) + o.shape[3:])


def causal_mla_attention(q, k, v):
    S = k.shape[1]
    kpos = jnp.arange(S)
    scale = (MLA_NOPE + MLA_ROPE) ** -0.5

    def block_fn(qblk, qpos):
        s = jnp.einsum("bqhd,bkhd->bhqk", qblk, k).astype(jnp.float32) * scale
        s = jnp.where(kpos[None, :] <= qpos[:, None], s, -jnp.inf)
        p = jax.nn.softmax(s, axis=-1)
        return jnp.einsum("bhqk,bkhd->bqhd", p.astype(v.dtype), v)

    return sweep_query_blocks(block_fn, q)


def causal_diff_attention(q, k, v, lam):
    S = k.shape[1]
    kpos = jnp.arange(S)
    scale = DIFF_QK ** -0.5

    def block_fn(qblk, qpos):
        s = jnp.einsum("bqhcd,bkhcd->bchqk", qblk, k).astype(jnp.float32) * scale
        s = jnp.where(kpos[None, :] <= qpos[:, None], s, -jnp.inf)
        p = jax.nn.softmax(s, axis=-1)
        a = p[:, 0] - lam * p[:, 1]
        return jnp.einsum("bhqk,bkhd->bqhd", a.astype(v.dtype), v)

    return sweep_query_blocks(block_fn, q)


def even_layer(h, w_in, conv_w, conv_b, gx_w, gx_b, ga_w, ga_b, lru_lambda, sinks, w_out):
    B, S, _ = h.shape
    z = h @ w_in
    lru_x, lru_gate, q, k, v, swa_gate = split_cols(z, EVEN_SPLITS)
    lru_x = causal_depthwise_conv(lru_x, conv_w, conv_b)
    y_a = rg_lru(lru_x, gx_w, gx_b, ga_w, ga_b, lru_lambda) * jax.nn.silu(lru_gate)
    q = q.reshape(B, S, SWA_Q_HEADS, SWA_HEAD_DIM)
    k = k.reshape(B, S, SWA_KV_HEADS, SWA_HEAD_DIM)
    v = v.reshape(B, S, SWA_KV_HEADS, SWA_HEAD_DIM)
    y_b = sliding_window_gqa_sinks(q, k, v, sinks) * jax.nn.silu(swa_gate)
    return jnp.concatenate([y_a, y_b], axis=-1) @ w_out


def odd_layer(h, w_in, q_norm, w_uq, kv_norm, w_ukv, lambda_q1, lambda_k1, lambda_q2, lambda_k2,
              subln, w_out):
    B, S, _ = h.shape
    pos = jnp.arange(S)
    z = h @ w_in
    c_q, c_kv, k_rope, mla_gate, dq, dk, dv, diff_gate = split_cols(z, ODD_SPLITS)
    q = (rmsnorm(c_q, q_norm) @ w_uq).reshape(B, S, MLA_HEADS, MLA_NOPE + MLA_ROPE)
    q = jnp.concatenate([q[..., :MLA_NOPE], rope(q[..., MLA_NOPE:], pos)], axis=-1)
    kv = (rmsnorm(c_kv, kv_norm) @ w_ukv).reshape(B, S, MLA_HEADS, MLA_NOPE + MLA_V)
    k_nope, v_c = kv[..., :MLA_NOPE], kv[..., MLA_NOPE:]
    k_r = rope(k_rope.reshape(B, S, 1, MLA_ROPE), pos)
    k_c = jnp.concatenate([k_nope, jnp.broadcast_to(k_r, (B, S, MLA_HEADS, MLA_ROPE))], axis=-1)
    y_c = causal_mla_attention(q, k_c, v_c).reshape(B, S, MLA_WIDTH) * jax.nn.silu(mla_gate)
    qd = dq.reshape(B, S, DIFF_HEADS, 2, DIFF_QK)
    kd = dk.reshape(B, S, DIFF_HEADS, 2, DIFF_QK)
    vd = dv.reshape(B, S, DIFF_HEADS, DIFF_V)
    lam = (jnp.exp(jnp.sum(lambda_q1.astype(jnp.float32) * lambda_k1.astype(jnp.float32)))
           - jnp.exp(jnp.sum(lambda_q2.astype(jnp.float32) * lambda_k2.astype(jnp.float32)))
           + DIFF_LAMBDA_INIT)
    od = causal_diff_attention(qd, kd, vd, lam)
    od = rmsnorm(od, subln) * (1.0 - DIFF_LAMBDA_INIT)
    y_d = od.reshape(B, S, DIFF_WIDTH) * jax.nn.silu(diff_gate)
    return jnp.concatenate([y_c, y_d], axis=-1) @ w_out


def setup_inputs(seed: int = 0) -> dict:
    key = jax.random.key(seed)
    ks = jax.random.split(key, 32)
    f32 = jnp.float32

    def dense(k, shape, fan_in):
        return jax.random.normal(k, shape, f32) * (fan_in ** -0.5)

    def gain(k, shape):
        return 1.0 + 0.05 * jax.random.normal(k, shape, f32)

    def small(k, shape, s=0.02):
        return s * jax.random.normal(k, shape, f32)

    u = jax.random.uniform(ks[10], (LRU_WIDTH,), f32, minval=0.9, maxval=0.999)
    a_base = u ** (1.0 / LRU_C)
    lru_lambda = jnp.log(a_base) - jnp.log1p(-a_base)

    return {
        "x": jax.random.normal(ks[0], (BATCH, SEQ, D_MODEL), f32),
        "norm_gains": gain(ks[1], (DEPTH, D_MODEL)),
        "final_norm_gain": gain(ks[2], (D_MODEL,)),
        "l0_w_in": dense(ks[3], (D_MODEL, EVEN_IN), D_MODEL),
        "l0_conv_w": dense(ks[4], (CONV_WIDTH, LRU_WIDTH), CONV_WIDTH),
        "l0_conv_b": small(ks[5], (LRU_WIDTH,)),
        "l0_gate_x_w": dense(ks[6], (LRU_BLOCKS, LRU_BLOCK_DIM, LRU_BLOCK_DIM), LRU_BLOCK_DIM),
        "l0_gate_x_b": small(ks[7], (LRU_BLOCKS, LRU_BLOCK_DIM)),
        "l0_gate_a_w": dense(ks[8], (LRU_BLOCKS, LRU_BLOCK_DIM, LRU_BLOCK_DIM), LRU_BLOCK_DIM),
        "l0_gate_a_b": small(ks[9], (LRU_BLOCKS, LRU_BLOCK_DIM)),
        "l0_lru_lambda": lru_lambda,
        "l0_sinks": 0.5 * jax.random.normal(ks[11], (SWA_Q_HEADS,), f32),
        "l0_w_out": dense(ks[12], (EVEN_MIX, D_MODEL), EVEN_MIX),
        "l1_w_in": dense(ks[13], (D_MODEL, ODD_IN), D_MODEL),
        "l1_q_norm": gain(ks[14], (MLA_Q_RANK,)),
        "l1_w_uq": dense(ks[15], (MLA_Q_RANK, MLA_HEADS * (MLA_NOPE + MLA_ROPE)), MLA_Q_RANK),
        "l1_kv_norm": gain(ks[16], (MLA_KV_RANK,)),
        "l1_w_ukv": dense(ks[17], (MLA_KV_RANK, MLA_HEADS * (MLA_NOPE + MLA_V)), MLA_KV_RANK),
        "l1_lambda_q1": small(ks[18], (DIFF_QK,), 0.1),
        "l1_lambda_k1": small(ks[19], (DIFF_QK,), 0.1),
        "l1_lambda_q2": small(ks[20], (DIFF_QK,), 0.1),
        "l1_lambda_k2": small(ks[21], (DIFF_QK,), 0.1),
        "l1_subln": gain(ks[22], (DIFF_V,)),
        "l1_w_out": dense(ks[23], (ODD_MIX, D_MODEL), ODD_MIX),
    }


def reference(x, norm_gains, final_norm_gain,
              l0_w_in, l0_conv_w, l0_conv_b, l0_gate_x_w, l0_gate_x_b, l0_gate_a_w, l0_gate_a_b,
              l0_lru_lambda, l0_sinks, l0_w_out,
              l1_w_in, l1_q_norm, l1_w_uq, l1_kv_norm, l1_w_ukv,
              l1_lambda_q1, l1_lambda_k1, l1_lambda_q2, l1_lambda_k2, l1_subln, l1_w_out):
    even_params = (l0_w_in, l0_conv_w, l0_conv_b, l0_gate_x_w, l0_gate_x_b, l0_gate_a_w,
                   l0_gate_a_b, l0_lru_lambda, l0_sinks, l0_w_out)
    odd_params = (l1_w_in, l1_q_norm, l1_w_uq, l1_kv_norm, l1_w_ukv, l1_lambda_q1, l1_lambda_k1,
                  l1_lambda_q2, l1_lambda_k2, l1_subln, l1_w_out)
    for layer in range(DEPTH):
        h = rmsnorm(x, norm_gains[layer])
        if layer % 2 == 0:
            x = x + even_layer(h, *even_params)
        else:
            x = x + odd_layer(h, *odd_params)
    return rmsnorm(x, final_norm_gain)
```

```cpp
#include <hip/hip_runtime.h>
#include <hip/hip_cooperative_groups.h>
#include <cstdio>
#include <cstdint>
namespace cg = cooperative_groups;

#ifndef MEGA
#define MEGA 1
#endif
#ifndef NAIVE_ATTN
#define NAIVE_ATTN 0
#endif

#define DI __device__ __forceinline__
typedef unsigned short bf16_t;
typedef short bf16x8 __attribute__((ext_vector_type(8)));
typedef float f32x16 __attribute__((ext_vector_type(16)));
typedef float f32x4 __attribute__((ext_vector_type(4)));
typedef float f32x2 __attribute__((ext_vector_type(2)));
typedef unsigned u32x4 __attribute__((ext_vector_type(4)));
typedef unsigned u32x2 __attribute__((ext_vector_type(2)));
typedef __bf16 bf2_t __attribute__((ext_vector_type(2)));

constexpr int T = 16384, S = 4096, NBATCH = 4, D = 2048;
constexpr int NTH = 512, NWV = 8;
constexpr int LDZ0 = 4352, LDZ1 = 6528, NPAD1 = 6656;
constexpr float EPS = 1e-6f;
constexpr float LOG2E = 1.4426950408889634f;
constexpr float LAMBDA_INIT = 0.35550906759096927f;

constexpr size_t al256(size_t b) { return (b + 255) & ~(size_t)255; }
constexpr size_t OFF_WT_IN0 = 0;
constexpr size_t OFF_WT_OUT0 = OFF_WT_IN0 + al256((size_t)4352 * 2048 * 2);
constexpr size_t OFF_WT_G = OFF_WT_OUT0 + al256((size_t)2048 * 2048 * 2);
constexpr size_t OFF_WT_IN1 = OFF_WT_G + al256((size_t)2048 * 128 * 2);
constexpr size_t OFF_WT_UQ = OFF_WT_IN1 + al256((size_t)NPAD1 * 2048 * 2);
constexpr size_t OFF_WT_UKV = OFF_WT_UQ + al256((size_t)1536 * 768 * 2);
constexpr size_t OFF_WT_OUT1 = OFF_WT_UKV + al256((size_t)2048 * 512 * 2);
constexpr size_t OFF_ROPE = OFF_WT_OUT1 + al256((size_t)2048 * 2048 * 2);
constexpr size_t OFF_H = OFF_ROPE + al256((size_t)4096 * 32 * 2 * 4);
constexpr size_t OFF_Z = OFF_H + al256((size_t)T * 2048 * 2);
constexpr size_t OFF_CARRY = OFF_Z + al256((size_t)T * LDZ1 * 2);
constexpr size_t OFF_VT0 = OFF_CARRY + al256((size_t)2 * NBATCH * 128 * 1024 * 4);
constexpr size_t OFF_Q1 = OFF_VT0 + al256((size_t)NBATCH * 2 * 64 * S * 2);
constexpr size_t OFF_KN = OFF_Q1 + al256((size_t)T * 1536 * 2);
constexpr size_t OFF_KR = OFF_KN + al256((size_t)T * 1024 * 2);
constexpr size_t OFF_VT1 = OFF_KR + al256((size_t)T * 64 * 2);
constexpr size_t OFF_VTD = OFF_VT1 + al256((size_t)T * 1024 * 2);
constexpr size_t OFF_CF = OFF_VTD + al256((size_t)T * 1024 * 2);
constexpr size_t OFF_BAR = OFF_CF + 4096;
constexpr size_t WS_NEEDED = OFF_BAR + 16384;

struct Params {
  const float *x, *norm_gains, *final_gain;
  const float *w_in0, *conv_w, *conv_b, *gx_w, *gx_b, *ga_w, *ga_b, *lru_lambda, *sinks, *w_out0;
  const float *w_in1, *q_norm, *w_uq, *kv_norm, *w_ukv, *lq1, *lk1, *lq2, *lk2, *subln, *w_out1;
  float* out;
  char* ws;
  DI bf16_t* wt_in0() const { return (bf16_t*)(ws + OFF_WT_IN0); }
  DI bf16_t* wt_out0() const { return (bf16_t*)(ws + OFF_WT_OUT0); }
  DI bf16_t* wt_g() const { return (bf16_t*)(ws + OFF_WT_G); }
  DI bf16_t* wt_in1() const { return (bf16_t*)(ws + OFF_WT_IN1); }
  DI bf16_t* wt_uq() const { return (bf16_t*)(ws + OFF_WT_UQ); }
  DI bf16_t* wt_ukv() const { return (bf16_t*)(ws + OFF_WT_UKV); }
  DI bf16_t* wt_out1() const { return (bf16_t*)(ws + OFF_WT_OUT1); }
  DI float* rope() const { return (float*)(ws + OFF_ROPE); }
  DI bf16_t* h() const { return (bf16_t*)(ws + OFF_H); }
  DI bf16_t* z() const { return (bf16_t*)(ws + OFF_Z); }
  DI bf16_t* xc() const { return (bf16_t*)(ws + OFF_Q1); }
  DI float* carry() const { return (float*)(ws + OFF_CARRY); }
  DI bf16_t* vt0() const { return (bf16_t*)(ws + OFF_VT0); }
  DI bf16_t* q1() const { return (bf16_t*)(ws + OFF_Q1); }
  DI bf16_t* kn() const { return (bf16_t*)(ws + OFF_KN); }
  DI bf16_t* kr() const { return (bf16_t*)(ws + OFF_KR); }
  DI bf16_t* vt1() const { return (bf16_t*)(ws + OFF_VT1); }
  DI bf16_t* vtd() const { return (bf16_t*)(ws + OFF_VTD); }
  DI float* cf() const { return (float*)(ws + OFF_CF); }
  DI unsigned* bar() const { return (unsigned*)(ws + OFF_BAR); }
  DI float* park() const { return (float*)ws; }
  DI float* av() const { return out; }
  DI float* uv() const { return out + (size_t)T * 1024; }
};

DI unsigned pk_bf16(float lo, float hi) {
  f32x2 v = {lo, hi};
  bf2_t r = __builtin_convertvector(v, bf2_t);
  return __builtin_bit_cast(unsigned, r);
}
DI bf16_t f2bf(float f) { return (bf16_t)(pk_bf16(f, 0.f) & 0xffffu); }
DI float bf2f(bf16_t v) { return __uint_as_float(((unsigned)v) << 16); }
DI float bflo(unsigned u) { return __uint_as_float(u << 16); }
DI float bfhi(unsigned u) { return __uint_as_float(u & 0xffff0000u); }
DI int otid() { int t = threadIdx.x; asm volatile("" : "+v"(t)); return t; }
DI float sigmoidf_(float v) { return 1.f / (1.f + __expf(-v)); }
DI float siluf_(float v) { return v / (1.f + __expf(-v)); }
DI float wave_sum(float v) {
#pragma unroll
  for (int o = 32; o > 0; o >>= 1) v += __shfl_xor(v, o);
  return v;
}
DI float wave_max(float v) {
#pragma unroll
  for (int o = 32; o > 0; o >>= 1) v = fmaxf(v, __shfl_xor(v, o));
  return v;
}

struct TJob { const float* W; int nsrc, src_col0; bf16_t* Wt; int K, dst_row0, k0; const float* kscale; int nvalid; bool valid; };
constexpr int TP = 132;
DI void transpose_tile(const TJob& j, int tid, float* lds  ) {
  __syncthreads();
  if (j.valid) {
    const int n4 = (tid & 31) * 4, kb = tid >> 5;
    f32x4 v[8];
#pragma unroll
    for (int i = 0; i < 8; ++i) {
      const int kk = kb + 8 * i;
      v[i] = (n4 < j.nvalid) ? *(const f32x4*)(j.W + (size_t)(j.k0 + kk) * j.nsrc + j.src_col0 + n4) : (f32x4){0.f, 0.f, 0.f, 0.f};
    }
#pragma unroll
    for (int i = 0; i < 8; ++i) {
      const int kk = kb + 8 * i;
      if (j.kscale) v[i] *= j.kscale[j.k0 + kk];
      *(f32x4*)(lds + kk * TP + n4) = v[i];
    }
  }
  __syncthreads();
  if (j.valid) {
    const int n = tid >> 1, kh = (tid & 1) * 32;
    bf16_t* dst = j.Wt + (size_t)(j.dst_row0 + n) * j.K + j.k0 + kh;
#pragma unroll
    for (int q = 0; q < 4; ++q) {
      u32x4 o;
      o.x = pk_bf16(lds[(kh + q * 8 + 0) * TP + n], lds[(kh + q * 8 + 1) * TP + n]);
      o.y = pk_bf16(lds[(kh + q * 8 + 2) * TP + n], lds[(kh + q * 8 + 3) * TP + n]);
      o.z = pk_bf16(lds[(kh + q * 8 + 4) * TP + n], lds[(kh + q * 8 + 5) * TP + n]);
      o.w = pk_bf16(lds[(kh + q * 8 + 6) * TP + n], lds[(kh + q * 8 + 7) * TP + n]);
      *(u32x4*)(dst + q * 8) = o;
    }
  }
}

DI void prep_weights(const Params& p, char* smem) {
  const int half = threadIdx.x >> 8, tid = threadIdx.x & 255;
  float* lds = (float*)smem + half * (64 * TP);
  constexpr int J0 = 34 * 32, J1 = 16 * 32, J3 = 52 * 32, J4 = 12 * 12, J5 = 16 * 8, J6 = 16 * 32;
  constexpr int TOT = J0 + J1 + J3 + J4 + J5 + J6;
  for (int t0 = blockIdx.x * 2; t0 < TOT; t0 += gridDim.x * 2) {
    const int t = t0 + half;
    TJob j{}; j.valid = t < TOT;
    int u = t;
    if (!j.valid) { }
    else if (u < J0) { const int nt = u / 32, kt = u % 32; j = TJob{p.w_in0, 4352, nt * 128, p.wt_in0(), 2048, nt * 128, kt * 64, nullptr, 128, true}; }
    else if ((u -= J0) < J1) { const int nt = u / 32, kt = u % 32; j = TJob{p.w_out0, 2048, nt * 128, p.wt_out0(), 2048, nt * 128, kt * 64, nullptr, 128, true}; }
    else if ((u -= J1) < J3) {
      const int nt = u / 32, kt = u % 32; const int r = nt * 128;
      int sc, nv = 128;
      if (r < 1280) sc = r; else if (r < 6400) sc = r + 64; else if (r < 6464) { sc = r - 6400 + 1280; nv = 64; } else { sc = 0; nv = 0; }
      j = TJob{p.w_in1, 6464, sc, p.wt_in1(), 2048, r, kt * 64, nullptr, nv, true};
    }
    else if ((u -= J3) < J4) { const int nt = u / 12, kt = u % 12; j = TJob{p.w_uq, 1536, nt * 128, p.wt_uq(), 768, nt * 128, kt * 64, p.q_norm, 128, true}; }
    else if ((u -= J4) < J5) { const int nt = u / 8, kt = u % 8; j = TJob{p.w_ukv, 2048, nt * 128, p.wt_ukv(), 512, nt * 128, kt * 64, p.kv_norm, 128, true}; }
    else { u -= J5; const int nt = u / 32, kt = u % 32; j = TJob{p.w_out1, 2048, nt * 128, p.wt_out1(), 2048, nt * 128, kt * 64, nullptr, 128, true}; }
    transpose_tile(j, tid, lds);
  }
  for (int i = blockIdx.x * NTH + otid(); i < 2048 * 16; i += gridDim.x * NTH) {
    const int r = i >> 4, d0 = (i & 15) * 8, gi = r >> 8, nl = r & 255, c32 = nl >> 6, which = (nl >> 5) & 1, e = c32 * 32 + (nl & 31);
    const float* src = (which ? p.ga_w : p.gx_w) + (size_t)gi * 128 * 128 + e;
    u32x4 o;
    o.x = pk_bf16(src[(d0 + 0) * 128], src[(d0 + 1) * 128]); o.y = pk_bf16(src[(d0 + 2) * 128], src[(d0 + 3) * 128]);
    o.z = pk_bf16(src[(d0 + 4) * 128], src[(d0 + 5) * 128]); o.w = pk_bf16(src[(d0 + 6) * 128], src[(d0 + 7) * 128]);
    *(u32x4*)(p.wt_g() + (size_t)r * 128 + d0) = o;
  }
  for (int i = blockIdx.x * NTH + otid(); i < 1024; i += gridDim.x * NTH) {
    const float nl = -p.lru_lambda[i];
    p.cf()[i] = -8.0f * (fmaxf(nl, 0.f) + log1pf(__expf(-fabsf(nl))));
  }
  for (int i = blockIdx.x * NTH + otid(); i < 4096 * 32; i += gridDim.x * NTH) {
    const int pos = i >> 5, fi = i & 31;
    const float freq = exp2f(-(float)fi * (13.287712379549449f / 32.f));
    double rev = (double)pos * (double)freq * 0.15915494309189535;
    rev -= floor(rev);
    const float rv = (float)rev;
    p.rope()[2 * i] = __builtin_amdgcn_cosf(rv);
    p.rope()[2 * i + 1] = __builtin_amdgcn_sinf(rv);
  }
}

DI void rmsnorm_phase(const float* __restrict__ X, const float* __restrict__ g, bf16_t* __restrict__ H, float* __restrict__ OF) {
  const int tid = otid(), lane = tid & 63;
  const int gw = blockIdx.x * NWV + (tid >> 6), nw = gridDim.x * NWV;
  for (int row = gw; row < T; row += nw) {
    const float* xr = X + (size_t)row * D;
    f32x4 v[8];
    float ss = 0.f;
#pragma unroll
    for (int i = 0; i < 8; ++i) { v[i] = *(const f32x4*)(xr + lane * 4 + 256 * i); ss += v[i][0] * v[i][0] + v[i][1] * v[i][1] + v[i][2] * v[i][2] + v[i][3] * v[i][3]; }
    ss = wave_sum(ss);
    const float rstd = rsqrtf(ss * (1.f / D) + EPS);
#pragma unroll
    for (int i = 0; i < 8; ++i) {
      const f32x4 gg = *(const f32x4*)(g + lane * 4 + 256 * i);
      f32x4 o = v[i] * rstd * gg;
      if (H) { u32x2 w; w.x = pk_bf16(o[0], o[1]); w.y = pk_bf16(o[2], o[3]); *(u32x2*)(H + (size_t)row * D + lane * 4 + 256 * i) = w; }
      else *(f32x4*)(OF + (size_t)row * D + lane * 4 + 256 * i) = o;
    }
  }
}

constexpr int GS = 72;
constexpr int G_TILE_EL = 256 * GS;
constexpr int G_STAGE_EL = 2 * G_TILE_EL;
constexpr int G_BYTES = 2 * G_STAGE_EL * 2;
constexpr int G_RSTD_OFF = G_BYTES;
constexpr int SMEM_BYTES = G_BYTES + 1024;

struct GTile { const bf16_t* A; int lda; const bf16_t* Bt; int ldb; int K, m0, n0; };
template <bool trans>
DI void gemm_core(const GTile& tl, const GTile& nx, bool has_next  , bool chain  , bool pre, u32x4 (&ra)[4], u32x4 (&rb)[4], char* smem, f32x16 (&acc)[2][4]) {
  const bf16_t* __restrict__ A = tl.A; const bf16_t* __restrict__ Bt = tl.Bt; const int lda = tl.lda, ldb = tl.ldb, K = tl.K, m0 = tl.m0, n0 = tl.n0;
  bf16_t* lds = (bf16_t*)smem;
  const int tid = otid(), lane = tid & 63, w = __builtin_amdgcn_readfirstlane(tid >> 6), wm = w >> 2, wn = w & 3, l32 = lane & 31, g = lane >> 5;
#pragma unroll
  for (int a = 0; a < 2; ++a)
#pragma unroll
    for (int b = 0; b < 4; ++b)
#pragma unroll
      for (int r = 0; r < 16; ++r) acc[a][b][r] = 0.f;
  const int lrow = tid >> 3, kc = tid & 7;
  const unsigned aoff = (unsigned)(lrow * lda + kc * 8) * 2u, boff = (unsigned)(lrow * ldb + kc * 8) * 2u;
  const char* ag = (const char*)(A + (size_t)m0 * lda);
  const char* bg = (const char*)(Bt + (size_t)n0 * ldb);
  const unsigned aoffn = (unsigned)(lrow * nx.lda + kc * 8) * 2u, boffn = (unsigned)(lrow * nx.ldb + kc * 8) * 2u;
  const char* agn = (const char*)(nx.A + (size_t)nx.m0 * nx.lda);
  const char* bgn = (const char*)(nx.Bt + (size_t)nx.n0 * nx.ldb);
#define G_LOAD(KT)                                                                                                 \
  {                                                                                                                \
    const int ko = (KT) * 64;                                                                                      \
    _Pragma("unroll") for (int i = 0; i < 4; ++i) ra[i] = *(const u32x4*)(ag + ((size_t)(64 * i) * lda + ko) * 2 + aoff); \
    _Pragma("unroll") for (int i = 0; i < 4; ++i) rb[i] = *(const u32x4*)(bg + ((size_t)(64 * i) * ldb + ko) * 2 + boff); \
  }
#define G_STORE(ST)                                                                                                \
  {                                                                                                                \
    bf16_t* la = lds + (ST) * G_STAGE_EL + lrow * GS + kc * 8;                                                     \
    _Pragma("unroll") for (int i = 0; i < 4; ++i) *(u32x4*)(la + 64 * i * GS) = ra[i];                             \
    _Pragma("unroll") for (int i = 0; i < 4; ++i) *(u32x4*)(la + G_TILE_EL + 64 * i * GS) = rb[i];                 \
  }
#define G_AF(KS, MB) (*(const bf16x8*)(ca + (MB) * 32 * GS + (KS) * 16))
#define G_M2(AF, MB)                                                                                               \
  {                                                                                                                \
    if (trans) { acc[0][MB] = __builtin_amdgcn_mfma_f32_32x32x16_bf16(AF, b0, acc[0][MB], 0, 0, 0);                \
                 acc[1][MB] = __builtin_amdgcn_mfma_f32_32x32x16_bf16(AF, b1, acc[1][MB], 0, 0, 0); }              \
    else { acc[0][MB] = __builtin_amdgcn_mfma_f32_32x32x16_bf16(b0, AF, acc[0][MB], 0, 0, 0);                      \
           acc[1][MB] = __builtin_amdgcn_mfma_f32_32x32x16_bf16(b1, AF, acc[1][MB], 0, 0, 0); }                    \
  }
#define G_KSTEP(KS)                                                                                                \
  {                                                                                                                \
    const bf16x8 b0 = *(const bf16x8*)(cb + (KS) * 16), b1 = *(const bf16x8*)(cb + 32 * GS + (KS) * 16);           \
    bf16x8 a0 = G_AF(KS, 0), a1 = G_AF(KS, 1);                                                                     \
    __builtin_amdgcn_s_setprio(1);     \
    G_M2(a0, 0); a0 = G_AF(KS, 2);                                                                                 \
    G_M2(a1, 1); a1 = G_AF(KS, 3);                                                                                 \
    G_M2(a0, 2);                                                                                                   \
    G_M2(a1, 3);                                                                                                   \
    __builtin_amdgcn_s_setprio(0);                                                                                 \
  }
#define G_PART(I, KT)                                                                                              \
  {                                                                                                                \
    if (do_store) {                                                                                                \
      bf16_t* la = lds + nst * G_STAGE_EL + lrow * GS + kc * 8;                                                    \
      *(u32x4*)(la + 64 * (I) * GS) = ra[I];                                                                       \
      *(u32x4*)(la + G_TILE_EL + 64 * (I) * GS) = rb[I];                                                           \
    }                                                                                                              \
    if (do_load) {                                                                                                 \
      const int ko = ((KT) + 2) * 64;                                                                              \
      ra[I] = *(const u32x4*)(ag + ((size_t)(64 * (I)) * lda + ko) * 2 + aoff);                                    \
      rb[I] = *(const u32x4*)(bg + ((size_t)(64 * (I)) * ldb + ko) * 2 + boff);                                    \
    } else if (chain) {                                                                                            \
      const int ko = ((KT) + 2 - nk) * 64;                                                                         \
      ra[I] = *(const u32x4*)(agn + ((size_t)(64 * (I)) * nx.lda + ko) * 2 + aoffn);                               \
      rb[I] = *(const u32x4*)(bgn + ((size_t)(64 * (I)) * nx.ldb + ko) * 2 + boffn);                               \
    }                                                                                                              \
  }
#define G_COMPUTE(ST, KT)                                                                                          \
  {                                                                                                                \
    const bf16_t* ca = lds + (ST) * G_STAGE_EL + (wm * 128 + l32) * GS + g * 8;                                    \
    const bf16_t* cb = lds + (ST) * G_STAGE_EL + G_TILE_EL + (wn * 64 + l32) * GS + g * 8;                         \
    const int nst = (ST) ^ 1;                                                                                      \
    const bool do_store = (KT) + 1 < nk || chain, do_load = (KT) + 2 < nk;                                         \
    G_PART(0, KT); G_KSTEP(0); __builtin_amdgcn_sched_barrier(0);                                                  \
    G_PART(1, KT); G_KSTEP(1); __builtin_amdgcn_sched_barrier(0);                                                  \
    G_PART(2, KT); G_KSTEP(2); __builtin_amdgcn_sched_barrier(0);                                                  \
    G_PART(3, KT); G_KSTEP(3); __builtin_amdgcn_sched_barrier(0);                                                  \
  }
  const int nk = K / 64;
  if (!pre) { G_LOAD(0); G_STORE(0); G_LOAD(1); }
  for (int kt = 0; kt < nk; ++kt) {
    __syncthreads();
    G_COMPUTE(kt & 1, kt);
  }
  if (!has_next) __syncthreads();
#undef G_LOAD
#undef G_STORE
#undef G_COMPUTE
#undef G_AF
#undef G_M2
#undef G_KSTEP
#undef G_PART
}

DI void gemm_half_rowbf16(const bf16_t* __restrict__ A, int lda, const bf16_t* __restrict__ Bt, int ldb, int K, int m0, int n0, char* smem, bf16_t* __restrict__ Out, int ldo) {
  bf16_t* lds = (bf16_t*)smem;
  const int tid = otid(), lane = tid & 63, w = __builtin_amdgcn_readfirstlane(tid >> 6), l32 = lane & 31, g = lane >> 5;
  f32x16 acc[4];
#pragma unroll
  for (int b = 0; b < 4; ++b)
#pragma unroll
    for (int r = 0; r < 16; ++r) acc[b][r] = 0.f;
  const int lrow = tid >> 3, kc = tid & 7;
  const unsigned aoff = (unsigned)(lrow * lda + kc * 8) * 2u, boff = (unsigned)(lrow * ldb + kc * 8) * 2u;
  const char* ag = (const char*)(A + (size_t)m0 * lda);
  const char* bg = (const char*)(Bt + (size_t)n0 * ldb);
  u32x4 ra[2], rb[4];
#define H_LOADA(I, KT) ra[I] = *(const u32x4*)(ag + ((size_t)(64 * (I)) * lda + (KT) * 64) * 2 + aoff)
#define H_LOADB(I, KT) rb[I] = *(const u32x4*)(bg + ((size_t)(64 * (I)) * ldb + (KT) * 64) * 2 + boff)
#define H_STOREA(ST, I) *(u32x4*)(lds + (ST) * G_STAGE_EL + lrow * GS + kc * 8 + 64 * (I) * GS) = ra[I]
#define H_STOREB(ST, I) *(u32x4*)(lds + (ST) * G_STAGE_EL + G_TILE_EL + lrow * GS + kc * 8 + 64 * (I) * GS) = rb[I]
#define H_FRAGS(F, ST, KS)                                                                                         \
  {                                                                                                                \
    const bf16_t* ca = lds + (ST) * G_STAGE_EL + l32 * GS + g * 8 + (KS) * 16;                                     \
    _Pragma("unroll") for (int mb = 0; mb < 4; ++mb) F[mb] = *(const bf16x8*)(ca + mb * 32 * GS);                  \
    F[4] = *(const bf16x8*)(lds + (ST) * G_STAGE_EL + G_TILE_EL + (w * 32 + l32) * GS + g * 8 + (KS) * 16);        \
  }
#define H_MMA(F) { _Pragma("unroll") for (int mb = 0; mb < 4; ++mb) acc[mb] = __builtin_amdgcn_mfma_f32_32x32x16_bf16(F[4], F[mb], acc[mb], 0, 0, 0); }
#define H_PART(I, ST, KT)                                                                                          \
  {                                                                                                                \
    if ((KT) + 1 < nk) { H_STOREB((ST) ^ 1, I); if ((I) < 2) H_STOREA((ST) ^ 1, (I) & 1); }                        \
    if ((KT) + 2 < nk) { H_LOADB(I, (KT) + 2); if ((I) < 2) H_LOADA((I) & 1, (KT) + 2); }                          \
  }
  const int nk = K / 64;
  H_LOADA(0, 0); H_LOADA(1, 0); H_LOADB(0, 0); H_LOADB(1, 0); H_LOADB(2, 0); H_LOADB(3, 0);
  H_STOREA(0, 0); H_STOREA(0, 1); H_STOREB(0, 0); H_STOREB(0, 1); H_STOREB(0, 2); H_STOREB(0, 3);
  if (nk > 1) { H_LOADA(0, 1); H_LOADA(1, 1); H_LOADB(0, 1); H_LOADB(1, 1); H_LOADB(2, 1); H_LOADB(3, 1); }
  for (int kt = 0; kt < nk; ++kt) {
    const int st = kt & 1;
    __syncthreads();
    bf16x8 f0[5], f1[5];
    H_FRAGS(f0, st, 0);
    H_PART(0, st, kt); H_FRAGS(f1, st, 1); H_MMA(f0); __builtin_amdgcn_sched_barrier(0);
    H_PART(1, st, kt); H_FRAGS(f0, st, 2); H_MMA(f1); __builtin_amdgcn_sched_barrier(0);
    H_PART(2, st, kt); H_FRAGS(f1, st, 3); H_MMA(f0); __builtin_amdgcn_sched_barrier(0);
    H_PART(3, st, kt); H_MMA(f1); __builtin_amdgcn_sched_barrier(0);
  }
  __syncthreads();
#undef H_LOADA
#undef H_LOADB
#undef H_STOREA
#undef H_STOREB
#undef H_FRAGS
#undef H_MMA
#undef H_PART
#pragma unroll
  for (int mb = 0; mb < 4; ++mb) {
    const size_t tok = m0 + 32 * mb + l32;
#pragma unroll
    for (int j = 0; j < 4; ++j) {
      const int n = n0 + 32 * w + 8 * j + 4 * g;
      u32x2 wv; wv.x = pk_bf16(acc[mb][4 * j], acc[mb][4 * j + 1]); wv.y = pk_bf16(acc[mb][4 * j + 2], acc[mb][4 * j + 3]);
      *(u32x2*)(Out + tok * ldo + n) = wv;
    }
  }
}

DI void store_bf4(bf16_t* dst, float a, float b, float c, float d) { u32x2 w; w.x = pk_bf16(a, b); w.y = pk_bf16(c, d); *(u32x2*)dst = w; }

DI void store_bf8_pair(bf16_t* rowp  , int g, u32x2 a  , u32x2 b  ) {
  auto rx = __builtin_amdgcn_permlane32_swap(a.x, b.x, false, false);
  auto ry = __builtin_amdgcn_permlane32_swap(a.y, b.y, false, false);
  u32x4 v = {rx[0], ry[0], rx[1], ry[1]};
  *(u32x4*)(rowp + 8 * g) = v;
}
struct EpiRowBf16 {
  bf16_t* O; int ld;
  DI void operator()(const f32x16 (&acc)[2][4], int mbase, int nbase, int l32, int g) const {
#pragma unroll
    for (int nb = 0; nb < 2; ++nb)
#pragma unroll
      for (int mb = 0; mb < 4; ++mb) {
        const size_t tok = mbase + 32 * mb + l32;
        const f32x16& c = acc[nb][mb];
#pragma unroll
        for (int j = 0; j < 4; j += 2) {
          u32x2 a, b;
          a.x = pk_bf16(c[4 * j], c[4 * j + 1]); a.y = pk_bf16(c[4 * j + 2], c[4 * j + 3]);
          b.x = pk_bf16(c[4 * j + 4], c[4 * j + 5]); b.y = pk_bf16(c[4 * j + 6], c[4 * j + 7]);
          store_bf8_pair(O + tok * ld + nbase + 32 * nb + 8 * j, g, a, b);
        }
      }
  }
};

struct EpiVt {
  bf16_t* O; int H, DV, ncol0; const float* rs; int m0;
  DI void operator()(const f32x16 (&acc)[2][4], int mbase, int nbase, int l32, int g) const {
#pragma unroll
    for (int nb = 0; nb < 2; ++nb) {
      const int n = nbase + 32 * nb + l32 - ncol0;
      const int head = n / DV, dv = n % DV;
#pragma unroll
      for (int mb = 0; mb < 4; ++mb)
#pragma unroll
        for (int j = 0; j < 4; ++j) {
          const int tok = mbase + 32 * mb + 8 * j + 4 * g;
          const int b = tok >> 12, s = tok & 4095;
          float v0 = acc[nb][mb][4 * j], v1 = acc[nb][mb][4 * j + 1], v2 = acc[nb][mb][4 * j + 2], v3 = acc[nb][mb][4 * j + 3];
          if (rs) { const f32x4 r4 = *(const f32x4*)(rs + (tok - m0)); v0 *= r4[0]; v1 *= r4[1]; v2 *= r4[2]; v3 *= r4[3]; }
          store_bf4(O + ((size_t)(b * H + head) * DV + dv) * S + s, v0, v1, v2, v3);
        }
    }
  }
};

struct EpiResid {
  const float* R; float* O;
  DI void operator()(const f32x16 (&acc)[2][4], int mbase, int nbase, int l32, int g) const {
#pragma unroll
    for (int nb = 0; nb < 2; ++nb)
#pragma unroll
      for (int mb = 0; mb < 4; ++mb) {
        const size_t tok = mbase + 32 * mb + l32;
#pragma unroll
        for (int j = 0; j < 4; ++j) {
          const int n = nbase + 32 * nb + 8 * j + 4 * g;
          f32x4 r = *(const f32x4*)(R + tok * D + n);
          r[0] += acc[nb][mb][4 * j]; r[1] += acc[nb][mb][4 * j + 1]; r[2] += acc[nb][mb][4 * j + 2]; r[3] += acc[nb][mb][4 * j + 3];
          *(f32x4*)(O + tok * D + n) = r;
        }
      }
  }
};

struct EpiGates {
  const Params* p; int ch0;
  DI void operator()(const f32x16 (&acc)[2][4], int mbase, int nbase, int l32, int g) const {
#pragma unroll
    for (int j = 0; j < 4; ++j) {
      const int ch = ch0 + 8 * j + 4 * g;
      const f32x4 bx = *(const f32x4*)(p->gx_b + ch), ba = *(const f32x4*)(p->ga_b + ch), cf = *(const f32x4*)(p->cf() + ch);
#pragma unroll
      for (int mb = 0; mb < 4; ++mb) {
        const size_t tok = mbase + 32 * mb + l32;
        const u32x2 xr = *(const u32x2*)(p->xc() + tok * 1024 + ch);
        const float xv[4] = {bflo(xr.x), bfhi(xr.x), bflo(xr.y), bfhi(xr.y)};
        f32x4 av, uv;
#pragma unroll
        for (int i = 0; i < 4; ++i) {
          const float gi = __builtin_amdgcn_rcpf(1.f + __expf(-(acc[0][mb][4 * j + i] + bx[i])));
          const float gr = __builtin_amdgcn_rcpf(1.f + __expf(-(acc[1][mb][4 * j + i] + ba[i])));
          const float la = cf[i] * gr;
          const float x2 = 2.f * la;
          const float ser = -x2 * (1.f + x2 * (0.5f + x2 * (0.16666667f + x2 * (0.041666668f + x2 * 0.0083333333f))));
          const float m2 = (x2 > -0.3f) ? ser : (1.f - __expf(x2));
          av[i] = __expf(la);
          uv[i] = sqrtf(fmaxf(m2, 0.f)) * gi * xv[i];
        }
        *(f32x4*)(p->av() + tok * 1024 + ch) = av;
        *(f32x4*)(p->uv() + tok * 1024 + ch) = uv;
      }
    }
  }
};

struct EpiRopeK {
  const Params* p;
  DI void operator()(const f32x16 (&acc)[2][4], int mbase, int nbase, int l32, int g) const {
    if (nbase != 6400) return;
#pragma unroll
    for (int mb = 0; mb < 4; ++mb) {
      const size_t tok = mbase + 32 * mb + l32;
      const int pos = (int)(tok & 4095);
#pragma unroll
      for (int j = 0; j < 4; ++j) {
        const int i0 = 8 * j + 4 * g;
        float o1[4], o2[4];
#pragma unroll
        for (int i = 0; i < 4; ++i) {
          const f32x2 cs = *(const f32x2*)(p->rope() + ((size_t)pos * 32 + i0 + i) * 2);
          const float x1 = acc[0][mb][4 * j + i], x2 = acc[1][mb][4 * j + i];
          o1[i] = x1 * cs[0] - x2 * cs[1]; o2[i] = x1 * cs[1] + x2 * cs[0];
        }
        store_bf4(p->kr() + tok * 64 + i0, o1[0], o1[1], o1[2], o1[3]);
        store_bf4(p->kr() + tok * 64 + 32 + i0, o2[0], o2[1], o2[2], o2[3]);
      }
    }
  }
};

struct EpiQ {
  const Params* p; const float* rs; int m0;
  DI void operator()(const f32x16 (&acc)[2][4], int mbase, int nbase, int l32, int g) const {
    const bool rp = ((nbase >> 6) % 3) == 2;
#pragma unroll
    for (int mb = 0; mb < 4; ++mb) {
      const size_t tok = mbase + 32 * mb + l32;
      const float r = rs[tok - m0];
      const int pos = (int)(tok & 4095);
#pragma unroll
      for (int j = 0; j < 4; ++j) {
        const int i0 = 8 * j + 4 * g;
        float o1[4], o2[4];
#pragma unroll
        for (int i = 0; i < 4; ++i) {
          const float x1 = acc[0][mb][4 * j + i] * r, x2 = acc[1][mb][4 * j + i] * r;
          if (rp) {
            const f32x2 cs = *(const f32x2*)(p->rope() + ((size_t)pos * 32 + i0 + i) * 2);
            o1[i] = x1 * cs[0] - x2 * cs[1]; o2[i] = x1 * cs[1] + x2 * cs[0];
          } else { o1[i] = x1; o2[i] = x2; }
        }
        store_bf4(p->q1() + tok * 1536 + nbase + i0, o1[0], o1[1], o1[2], o1[3]);
        store_bf4(p->q1() + tok * 1536 + nbase + 32 + i0, o2[0], o2[1], o2[2], o2[3]);
      }
    }
  }
};

struct EpiKn {
  const Params* p; const float* rs; int m0; int head; int n0;
  DI void operator()(const f32x16 (&acc)[2][4], int mbase, int nbase, int l32, int g) const {
#pragma unroll
    for (int nb = 0; nb < 2; ++nb)
#pragma unroll
      for (int mb = 0; mb < 4; ++mb) {
        const size_t tok = mbase + 32 * mb + l32;
        const float r = rs[tok - m0];
#pragma unroll
        for (int j = 0; j < 4; ++j) {
          const int n = nbase - n0 + 32 * nb + 8 * j + 4 * g;
          store_bf4(p->kn() + tok * 1024 + head * 128 + n, acc[nb][mb][4 * j] * r, acc[nb][mb][4 * j + 1] * r, acc[nb][mb][4 * j + 2] * r, acc[nb][mb][4 * j + 3] * r);
        }
      }
  }
};

DI void row_rstd(const bf16_t* __restrict__ A, int lda, int K, int m0, float* rs) {
  const int tid = otid();
  const bf16_t* r = A + (size_t)(m0 + (tid >> 1)) * lda + (tid & 1) * (K / 2);
  float ss = 0.f;
  for (int c = 0; c < K / 2; c += 8) {
    const u32x4 v = *(const u32x4*)(r + c);
    ss += bflo(v.x) * bflo(v.x) + bfhi(v.x) * bfhi(v.x) + bflo(v.y) * bflo(v.y) + bfhi(v.y) * bfhi(v.y) +
          bflo(v.z) * bflo(v.z) + bfhi(v.z) * bfhi(v.z) + bflo(v.w) * bflo(v.w) + bfhi(v.w) * bfhi(v.w);
  }
  ss += __shfl_xor(ss, 1);
  if ((tid & 1) == 0) rs[tid >> 1] = rsqrtf(ss / (float)K + EPS);
  __syncthreads();
}

#define WAVE_GEOM const int tid_ = otid(), w_ = __builtin_amdgcn_readfirstlane(tid_ >> 6), wm_ = w_ >> 2, wn_ = w_ & 3, l32_ = tid_ & 31, g_ = (tid_ >> 5) & 1
DI void phase_gemm_in0(const Params& p, char* smem) {
  u32x4 ra[4], rb[4]; bool pre = false;
  for (int t = blockIdx.x; t < 64 * 16; t += gridDim.x) {
    const int mt = t & 63, nt = t >> 6, tn = t + gridDim.x;
    const bool has_next = tn < 64 * 16;
    const GTile tl{p.h(), D, p.wt_in0(), D, D, mt * 256, nt * 256}, nx{p.h(), D, p.wt_in0(), D, D, (tn & 63) * 256, (tn >> 6) * 256};
    WAVE_GEOM;
    const bool trans = nt == 12 && wn_ >= 2;
    if (trans) { f32x16 acc[2][4]; gemm_core<true>(tl, nx, has_next, false, pre, ra, rb, smem, acc);
      EpiVt e{p.vt0(), 2, 64, 3200, nullptr, 0}; e(acc, mt * 256 + wm_ * 128, nt * 256 + wn_ * 64, l32_, g_); }
    else { f32x16 acc[2][4]; gemm_core<false>(tl, nx, has_next, has_next, pre, ra, rb, smem, acc);
      EpiRowBf16 e{p.z(), LDZ0}; e(acc, mt * 256 + wm_ * 128, nt * 256 + wn_ * 64, l32_, g_); }
    pre = has_next && !trans;
  }
  for (int t = blockIdx.x; t < 128; t += gridDim.x) gemm_half_rowbf16(p.h(), D, p.wt_in0(), D, D, t * 128, 16 * 256, smem, p.z(), LDZ0);
}
DI void phase_conv(const Params& p) {
  for (int i = blockIdx.x * NTH + otid(); i < T * 128; i += gridDim.x * NTH) {
    const int tok = i >> 7, c = (i & 127) * 8, s = tok & 4095;
    float o[8];
#pragma unroll
    for (int e = 0; e < 8; ++e) o[e] = p.conv_b[c + e];
#pragma unroll
    for (int k = 0; k < 4; ++k) {
      const int ss = s - 3 + k;
      if (ss < 0) continue;
      const u32x4 v = *(const u32x4*)(p.z() + (size_t)(tok - 3 + k) * LDZ0 + c);
      const float* wk = p.conv_w + k * 1024 + c;
      o[0] += wk[0] * bflo(v.x); o[1] += wk[1] * bfhi(v.x); o[2] += wk[2] * bflo(v.y); o[3] += wk[3] * bfhi(v.y);
      o[4] += wk[4] * bflo(v.z); o[5] += wk[5] * bfhi(v.z); o[6] += wk[6] * bflo(v.w); o[7] += wk[7] * bfhi(v.w);
    }
    u32x4 w; w.x = pk_bf16(o[0], o[1]); w.y = pk_bf16(o[2], o[3]); w.z = pk_bf16(o[4], o[5]); w.w = pk_bf16(o[6], o[7]);
    *(u32x4*)(p.xc() + (size_t)tok * 1024 + c) = w;
  }
}
DI void phase_gates(const Params& p, char* smem) {
  u32x4 ra[4], rb[4]; bool pre = false;
  for (int t = blockIdx.x; t < 64 * 8; t += gridDim.x) {
    const int mt = t & 63, gi = t >> 6, tn = t + gridDim.x;
    const bool has_next = tn < 64 * 8;
    const GTile tl{p.xc() + gi * 128, 1024, p.wt_g(), 128, 128, mt * 256, gi * 256}, nx{p.xc() + (tn >> 6) * 128, 1024, p.wt_g(), 128, 128, (tn & 63) * 256, (tn >> 6) * 256};
    WAVE_GEOM;
    f32x16 acc[2][4];
    gemm_core<false>(tl, nx, has_next, has_next, pre, ra, rb, smem, acc);
    EpiGates e{&p, gi * 128 + wn_ * 32};
    e(acc, mt * 256 + wm_ * 128, gi * 256 + wn_ * 64, l32_, g_);
    pre = true;
  }
}
DI void phase_scan_local(const Params& p) {
  for (int i = blockIdx.x * NTH + otid(); i < NBATCH * 128 * 256; i += gridDim.x * NTH) {
    const int ch = (i & 255) * 4, c = (i >> 8) & 127, b = i >> 15;
    const size_t base = ((size_t)b * S + c * 32) * 1024 + ch;
    f32x4 A = {1.f, 1.f, 1.f, 1.f}, H = {0.f, 0.f, 0.f, 0.f};
#pragma unroll 1
    for (int t0 = 0; t0 < 32; t0 += 8) {
      f32x4 a[8], u[8];
#pragma unroll
      for (int j = 0; j < 8; ++j) { a[j] = *(const f32x4*)(p.av() + base + (size_t)(t0 + j) * 1024); u[j] = *(const f32x4*)(p.uv() + base + (size_t)(t0 + j) * 1024); }
#pragma unroll
      for (int j = 0; j < 8; ++j) { A *= a[j]; H = a[j] * H + u[j]; }
    }
    *(f32x4*)(p.carry() + (size_t)i * 4) = A; *(f32x4*)(p.carry() + (size_t)NBATCH * 128 * 1024 + (size_t)i * 4) = H;
  }
}
DI void phase_scan_fix(const Params& p) {
  for (int i = blockIdx.x * NTH + otid(); i < NBATCH * 128 * 256; i += gridDim.x * NTH) {
    const int ch = (i & 255) * 4, c = (i >> 8) & 127, b = i >> 15;
    f32x4 h = {0.f, 0.f, 0.f, 0.f};
    const float* cA = p.carry() + ((size_t)b * 128 * 256 + (i & 255)) * 4;
    const float* cH = cA + (size_t)NBATCH * 128 * 1024;
    int cc = 0;
#pragma unroll 1
    for (; cc + 8 <= c; cc += 8) {
      f32x4 a[8], u[8];
#pragma unroll
      for (int j = 0; j < 8; ++j) { a[j] = *(const f32x4*)(cA + (size_t)(cc + j) * 1024); u[j] = *(const f32x4*)(cH + (size_t)(cc + j) * 1024); }
#pragma unroll
      for (int j = 0; j < 8; ++j) h = a[j] * h + u[j];
    }
    for (; cc < c; ++cc) h = *(const f32x4*)(cA + (size_t)cc * 1024) * h + *(const f32x4*)(cH + (size_t)cc * 1024);
    const size_t tok0 = (size_t)b * S + c * 32;
#pragma unroll 1
    for (int t0 = 0; t0 < 32; t0 += 8) {
      f32x4 a[8], u[8]; u32x2 gt[8];
#pragma unroll
      for (int j = 0; j < 8; ++j) {
        const size_t tok = tok0 + t0 + j;
        a[j] = *(const f32x4*)(p.av() + tok * 1024 + ch); u[j] = *(const f32x4*)(p.uv() + tok * 1024 + ch);
        gt[j] = *(const u32x2*)(p.z() + tok * LDZ0 + 1024 + ch);
      }
#pragma unroll
      for (int j = 0; j < 8; ++j) {
        h = a[j] * h + u[j];
        store_bf4(p.h() + (tok0 + t0 + j) * D + ch, h[0] * siluf_(bflo(gt[j].x)), h[1] * siluf_(bfhi(gt[j].x)), h[2] * siluf_(bflo(gt[j].y)), h[3] * siluf_(bfhi(gt[j].y)));
      }
    }
  }
}
DI void phase_gemm_out(const Params& p, char* smem, const bf16_t* Wt, const float* R, float* O) {
  u32x4 ra[4], rb[4]; bool pre = false;
  for (int t = blockIdx.x; t < 64 * 8; t += gridDim.x) {
    const int mt = t & 63, nt = t >> 6, tn = t + gridDim.x;
    const bool has_next = tn < 64 * 8;
    const GTile tl{p.h(), D, Wt, D, D, mt * 256, nt * 256}, nx{p.h(), D, Wt, D, D, (tn & 63) * 256, (tn >> 6) * 256};
    WAVE_GEOM;
    f32x16 acc[2][4];
    gemm_core<false>(tl, nx, has_next, has_next, pre, ra, rb, smem, acc);
    const float* Rq = R; asm volatile("" : "+s"(Rq));
    EpiResid e{Rq, O};
    e(acc, mt * 256 + wm_ * 128, nt * 256 + wn_ * 64, l32_, g_);
    pre = true;
  }
}
DI int in1_nt(int t) { return (t >> 6) < 23 ? (t >> 6) : 25; }
DI void phase_gemm_in1(const Params& p, char* smem) {
  u32x4 ra[4], rb[4]; bool pre = false;
  for (int t = blockIdx.x; t < 64 * 24; t += gridDim.x) {
    const int mt = t & 63, nt = in1_nt(t), tn = t + gridDim.x;
    const bool has_next = tn < 64 * 24;
    const GTile tl{p.h(), D, p.wt_in1(), D, D, mt * 256, nt * 256}, nx{p.h(), D, p.wt_in1(), D, D, (tn & 63) * 256, in1_nt(tn) * 256};
    WAVE_GEOM;
    const bool trans = nt >= 17 && nt < 21;
    const int mbase = mt * 256 + wm_ * 128, nbase = nt * 256 + wn_ * 64;
    if (trans) { f32x16 acc[2][4]; gemm_core<true>(tl, nx, has_next, false, pre, ra, rb, smem, acc); EpiVt e{p.vtd(), 8, 128, 4352, nullptr, 0}; e(acc, mbase, nbase, l32_, g_); }
    else { f32x16 acc[2][4]; gemm_core<false>(tl, nx, has_next, has_next, pre, ra, rb, smem, acc);
      if (nt == 25) { EpiRopeK e{&p}; e(acc, mbase, nbase, l32_, g_); }
      else { EpiRowBf16 e{p.z(), LDZ1}; e(acc, mbase, nbase, l32_, g_); } }
    pre = has_next && !trans;
  }
  for (int t = blockIdx.x; t < 256; t += gridDim.x) gemm_half_rowbf16(p.h(), D, p.wt_in1(), D, D, (t & 127) * 128, (23 + (t >> 7)) * 256, smem, p.z(), LDZ1);
}
DI GTile up_tile(const Params& p, int t) {
  const int mt = t & 63, nt = t >> 6;
  if (nt < 6) return GTile{p.z(), LDZ1, p.wt_uq(), 768, 768, mt * 256, nt * 256};
  return GTile{p.z() + 768, LDZ1, p.wt_ukv(), 512, 512, mt * 256, (nt - 6) * 256};
}
DI void phase_up(const Params& p, char* smem) {
  float* rs = (float*)(smem + G_RSTD_OFF);
  u32x4 ra[4], rb[4]; bool pre = false;
  for (int t = blockIdx.x; t < 64 * 14; t += gridDim.x) {
    const int mt = t & 63, nt = t >> 6, tn = t + gridDim.x;
    const bool has_next = tn < 64 * 14;
    const GTile tl = up_tile(p, t), nx = up_tile(p, has_next ? tn : t);
    WAVE_GEOM;
    const int mbase = mt * 256 + wm_ * 128;
    if (nt < 6) {
      f32x16 acc[2][4];
      row_rstd(p.z(), LDZ1, 768, mt * 256, rs);
      gemm_core<false>(tl, nx, has_next, has_next, pre, ra, rb, smem, acc);
      EpiQ e{&p, rs, mt * 256};
      e(acc, mbase, nt * 256 + wn_ * 64, l32_, g_);
    } else {
      const int head = nt - 6;
      const bool trans = wn_ >= 2;
      row_rstd(p.z() + 768, LDZ1, 512, mt * 256, rs);
      if (trans) { f32x16 acc[2][4]; gemm_core<true>(tl, nx, has_next, false, pre, ra, rb, smem, acc);
        EpiVt e{p.vt1(), 8, 128, head * 128 + 128, rs, mt * 256}; e(acc, mbase, head * 256 + wn_ * 64, l32_, g_); }
      else { f32x16 acc[2][4]; gemm_core<false>(tl, nx, has_next, has_next, pre, ra, rb, smem, acc);
        EpiKn e{&p, rs, mt * 256, head, head * 256}; e(acc, mbase, head * 256 + wn_ * 64, l32_, g_); }
    }
    pre = has_next && !(nt >= 6 && wn_ >= 2);
    __syncthreads();
  }
}

DI float diff_lambda(const Params& p) {
  float a = 0.f, b = 0.f;
  for (int i = 0; i < 64; ++i) { a += p.lq1[i] * p.lk1[i]; b += p.lq2[i] * p.lk2[i]; }
  return __expf(a) - __expf(b) + LAMBDA_INIT;
}

template <int DQK, int NMAP, int DV>
DI void attn_core(const bf16_t* __restrict__ q, int qs, const bf16_t* __restrict__ k0, int ks0, int w0, const bf16_t* __restrict__ k1, int ks1,
                  const bf16_t* __restrict__ vt, int q0, int kt_lo, int kt_hi, float sc, float m_init, float l_init, int window, char* smem,
                  f32x16 (&O)[NMAP][DV / 32], float (&lsum)[NMAP]) {
  constexpr int KW = DQK * NMAP, KS = KW + 8, CPR = KW / 8, NKC = 64 * CPR / NTH, NVC = DV * 8 / NTH, VS = 68, NDB = DV / 32, NKS = DQK / 16;
  constexpr int K_EL = 64 * KS, V_EL = DV * VS, ST_EL = K_EL + V_EL;
  static_assert(64 * CPR % NTH == 0 && DV * 8 % NTH == 0 && 2 * ST_EL * 2 <= G_BYTES, "attention tile shape");
  bf16_t* lds = (bf16_t*)smem;
  const int tid = otid(), lane = tid & 63, w = __builtin_amdgcn_readfirstlane(tid >> 6), l32 = lane & 31, g = lane >> 5;
  bf16x8 qf[NMAP][NKS];
  {
    const bf16_t* qrow = q + (size_t)(q0 + 32 * w + l32) * qs + 8 * g;
#pragma unroll
    for (int c = 0; c < NMAP; ++c)
#pragma unroll
      for (int ks = 0; ks < NKS; ++ks) qf[c][ks] = *(const bf16x8*)(qrow + c * DQK + 16 * ks);
  }
  float m[NMAP];
#pragma unroll
  for (int c = 0; c < NMAP; ++c) {
    m[c] = m_init; lsum[c] = g == 0 ? l_init : 0.f;
#pragma unroll
    for (int db = 0; db < NDB; ++db)
#pragma unroll
      for (int r = 0; r < 16; ++r) O[c][db][r] = 0.f;
  }
  u32x4 rk[NKC], rv[NVC];
#define ATTN_LOAD_K(KT)                                                                                            \
  {                                                                                                                \
    _Pragma("unroll") for (int i = 0; i < NKC; ++i) {                                                              \
      const int c = tid + NTH * i, key = c / CPR, col = (c % CPR) * 8;                                             \
      const size_t kg = (size_t)(KT) * 64 + key;                                                                   \
      const bf16_t* src = col < w0 ? k0 + kg * ks0 + col : k1 + kg * ks1 + (col - w0);                             \
      rk[i] = *(const u32x4*)src;                                                                                  \
    }                                                                                                              \
  }
#define ATTN_LOAD_V(KT)                                                                                            \
  {                                                                                                                \
    _Pragma("unroll") for (int i = 0; i < NVC; ++i) {                                                              \
      const int c = tid + NTH * i, dv = c >> 3, kc = c & 7;                                                        \
      rv[i] = *(const u32x4*)(vt + (size_t)dv * S + (KT) * 64 + kc * 8);                                           \
    }                                                                                                              \
  }
#define ATTN_LOAD(KT) { ATTN_LOAD_K(KT); ATTN_LOAD_V(KT); }
#define ATTN_STORE_K(ST)                                                                                           \
  {                                                                                                                \
    bf16_t* kb = lds + (ST) * ST_EL;                                                                               \
    _Pragma("unroll") for (int i = 0; i < NKC; ++i) {                                                              \
      const int c = tid + NTH * i, key = c / CPR, col = (c % CPR) * 8;                                             \
      *(u32x4*)(kb + key * KS + col) = rk[i];                                                                      \
    }                                                                                                              \
  }
#define ATTN_STORE_V(ST)                                                                                           \
  {                                                                                                                \
    bf16_t* vb = lds + (ST) * ST_EL + K_EL;                                                                        \
    _Pragma("unroll") for (int i = 0; i < NVC; ++i) {                                                              \
      const int c = tid + NTH * i, dv = c >> 3, kc = c & 7;                                                        \
      u32x2* d = (u32x2*)(vb + dv * VS + kc * 8);                                                                  \
      u32x2 lo = {rv[i].x, rv[i].y}, hi = {rv[i].z, rv[i].w};                                                      \
      d[0] = lo; d[1] = hi;                                                                                        \
    }                                                                                                              \
  }
#define ATTN_STORE(ST) { ATTN_STORE_K(ST); ATTN_STORE_V(ST); }
  ATTN_LOAD(kt_lo);
  ATTN_STORE(0);
  if (kt_lo < kt_hi) ATTN_LOAD(kt_lo + 1);
  const int qmin = q0 + 32 * w, qmax = qmin + 31, qpos = qmin + l32;
  for (int kt = kt_lo; kt <= kt_hi; ++kt) {
    const int cur = (kt - kt_lo) & 1;
    __syncthreads();
    if (kt < kt_hi) ATTN_STORE_K(cur ^ 1);
    if (kt + 1 < kt_hi) ATTN_LOAD_K(kt + 2);
    const int kmin0 = kt * 64;
    const bool act0 = kmin0 <= qmax && (window == 0 || kmin0 + 31 > qmin - window);
    const bool act1 = kmin0 + 32 <= qmax && (window == 0 || kmin0 + 63 > qmin - window);
    const bf16_t* kbase = lds + cur * ST_EL + l32 * KS + 8 * g;
    const bf16_t* vbase = lds + cur * ST_EL + K_EL + l32 * VS + 4 * g;
#pragma unroll
    for (int c = 0; c < NMAP; ++c) {
      f32x16 sa0, sa1;
#pragma unroll
      for (int r = 0; r < 16; ++r) { sa0[r] = 0.f; sa1[r] = 0.f; }
#define ATTN_QK(SA, KP)                                                                                            \
      {                                                                                                            \
        constexpr int PF = NKS < 4 ? NKS : 4;                                                                      \
        bf16x8 kf[PF];                                                                                             \
        _Pragma("unroll") for (int ks = 0; ks < PF; ++ks) kf[ks] = *(const bf16x8*)((KP) + 16 * ks);               \
        __builtin_amdgcn_sched_barrier(0);                                                                         \
        _Pragma("unroll") for (int ks = 0; ks < NKS; ++ks) {                                                       \
          SA = __builtin_amdgcn_mfma_f32_32x32x16_bf16(kf[ks % PF], qf[c][ks], SA, 0, 0, 0);                       \
          if (ks + PF < NKS) kf[ks % PF] = *(const bf16x8*)((KP) + 16 * (ks + PF));                                \
          __builtin_amdgcn_sched_barrier(0);                                                                       \
        }                                                                                                          \
      }
      if (act0) ATTN_QK(sa0, kbase + c * DQK);
      if (act1) ATTN_QK(sa1, kbase + 32 * KS + c * DQK);
#undef ATTN_QK
      if (c == NMAP - 1) {
        if (kt < kt_hi) ATTN_STORE_V(cur ^ 1);
        if (kt + 1 < kt_hi) ATTN_LOAD_V(kt + 2);
      }
#define ATTN_HALF(SA, HK)                                                                                          \
      {                                                                                                            \
        const int kmin = kmin0 + (HK) * 32, kmax = kmin + 31;                                                      \
        const bool need_mask = kmax > qmin || (window != 0 && kmin <= qmax - window);                              \
        if (need_mask) {     \
          asm volatile("" ::: "memory");                                                                           \
          const int lim = qpos - kmin - 4 * g;     \
          _Pragma("unroll") for (int r = 0; r < 16; ++r) {                                                         \
            const int ro = 8 * (r >> 2) + (r & 3);                                                                 \
            const bool vis = (unsigned)(lim - ro) < (window ? (unsigned)window : 0x7fffffffu);     \
            SA[r] = vis ? SA[r] : -1e30f;                                                                          \
          }                                                                                                        \
        }                                                                                                          \
        float mx = -1e30f;                                                                                         \
        _Pragma("unroll") for (int r = 0; r < 16; ++r) mx = fmaxf(mx, SA[r]);                                      \
          \
          \
          \
        float alpha = 1.f;                                                                                         \
        const bool resc = !__all(mx * sc - m[c] <= 8.f);                                                           \
        if (resc) {                                                                                                \
          auto sw = __builtin_amdgcn_permlane32_swap(__float_as_uint(mx), __float_as_uint(mx), false, false);      \
          const float mn = fmaxf(m[c], fmaxf(__uint_as_float(sw[0]), __uint_as_float(sw[1])) * sc);                \
          alpha = __builtin_amdgcn_exp2f(m[c] - mn); m[c] = mn;                                                    \
        }                                                                                                          \
        const float mcur = m[c];                                                                                   \
        float ps = 0.f;                                                                                            \
        _Pragma("unroll") for (int r = 0; r < 16; ++r) { SA[r] = __builtin_amdgcn_exp2f(__builtin_fmaf(SA[r], sc, -mcur)); ps += SA[r]; } \
        lsum[c] = lsum[c] * alpha + ps;                                                                            \
        bf16x8 pf[2];                                                                                              \
        _Pragma("unroll") for (int s2 = 0; s2 < 2; ++s2) {                                                         \
          u32x4 pk;                                                                                                \
          pk.x = pk_bf16(SA[8 * s2 + 0], SA[8 * s2 + 1]); pk.y = pk_bf16(SA[8 * s2 + 2], SA[8 * s2 + 3]);          \
          pk.z = pk_bf16(SA[8 * s2 + 4], SA[8 * s2 + 5]); pk.w = pk_bf16(SA[8 * s2 + 6], SA[8 * s2 + 7]);          \
          pf[s2] = __builtin_bit_cast(bf16x8, pk);                                                                 \
        }                                                                                                          \
        if (resc) {     \
          asm volatile("" ::: "memory");                                                                           \
          _Pragma("unroll") for (int db = 0; db < NDB; ++db)                                                       \
            _Pragma("unroll") for (int r = 0; r < 16; ++r) O[c][db][r] *= alpha;                                   \
        }                                                                                                          \
        const bf16_t* vb = vbase + (HK) * 32;                                                                      \
        u32x4 vf[4];                                                                                               \
        _Pragma("unroll") for (int i = 0; i < 4; ++i) {                                                            \
          const u32x2 lo = *(const u32x2*)(vb + (i >> 1) * 32 * VS + 16 * (i & 1));                                \
          const u32x2 hi = *(const u32x2*)(vb + (i >> 1) * 32 * VS + 16 * (i & 1) + 8);                            \
          vf[i] = (u32x4){lo.x, lo.y, hi.x, hi.y};                                                                 \
        }                                                                                                          \
        __builtin_amdgcn_sched_barrier(0);                                                                         \
        _Pragma("unroll") for (int i = 0; i < 2 * NDB; ++i) {                                                      \
          O[c][i >> 1] = __builtin_amdgcn_mfma_f32_32x32x16_bf16(__builtin_bit_cast(bf16x8, vf[i & 3]), pf[i & 1], O[c][i >> 1], 0, 0, 0); \
          if (i + 4 < 2 * NDB) {                                                                                   \
            const int n = i + 4;                                                                                   \
            const u32x2 lo = *(const u32x2*)(vb + (n >> 1) * 32 * VS + 16 * (n & 1));                              \
            const u32x2 hi = *(const u32x2*)(vb + (n >> 1) * 32 * VS + 16 * (n & 1) + 8);                          \
            vf[i & 3] = (u32x4){lo.x, lo.y, hi.x, hi.y};                                                           \
          }                                                                                                        \
          __builtin_amdgcn_sched_barrier(0);                                                                       \
        }                                                                                                          \
      }
      if (act0) ATTN_HALF(sa0, 0);
      if (act1) ATTN_HALF(sa1, 1);
#undef ATTN_HALF
    }
  }
  __syncthreads();
#undef ATTN_LOAD
#undef ATTN_STORE
#undef ATTN_LOAD_K
#undef ATTN_LOAD_V
#undef ATTN_STORE_K
#undef ATTN_STORE_V
#pragma unroll
  for (int c = 0; c < NMAP; ++c) lsum[c] += __shfl_xor(lsum[c], 32);
}

DI void attn_store_gated(bf16_t* yrow, const bf16_t* grow, const f32x16& o, float inv, int db, int g) {
#pragma unroll
  for (int j = 0; j < 4; ++j) {
    const int dv = 32 * db + 8 * j + 4 * g;
    const u32x2 gr = *(const u32x2*)(grow + dv);
    store_bf4(yrow + dv, o[4 * j] * inv * siluf_(bflo(gr.x)), o[4 * j + 1] * inv * siluf_(bfhi(gr.x)), o[4 * j + 2] * inv * siluf_(bflo(gr.y)), o[4 * j + 3] * inv * siluf_(bfhi(gr.y)));
  }
}

DI void swa_item(const Params& p, int it, char* smem) {
  const int qh = it & 15, qt = (it >> 4) & 15, b = it >> 8, kvh = qh >> 3;
  const int tid_ = otid(), lane = tid_ & 63, w = tid_ >> 6, l32 = lane & 31, g = lane >> 5;
  f32x16 O[1][2]; float ls[1];
  const bf16_t* zb = p.z() + (size_t)b * S * LDZ0;
  attn_core<64, 1, 64>(zb + 2048 + qh * 64, LDZ0, zb + 3072 + kvh * 64, LDZ0, 64, nullptr, 0, p.vt0() + (size_t)(b * 2 + kvh) * 64 * S,
                       qt * 256, max(0, qt * 4 - 2), qt * 4 + 3, 0.125f * LOG2E, p.sinks[qh] * LOG2E, 1.f, 128, smem, O, ls);
  const size_t tok = (size_t)b * S + qt * 256 + 32 * w + l32;
  const float inv = 1.f / ls[0];
#pragma unroll
  for (int db = 0; db < 2; ++db) attn_store_gated(p.h() + tok * D + 1024 + qh * 64, p.z() + tok * LDZ0 + 3328 + qh * 64, O[0][db], inv, db, g);
}
DI void mla_item(const Params& p, int b, int hh, int qt, char* smem) {
  const int tid_ = otid(), lane = tid_ & 63, w = tid_ >> 6, l32 = lane & 31, g = lane >> 5;
  f32x16 O[1][4]; float ls[1];
  attn_core<192, 1, 128>(p.q1() + (size_t)b * S * 1536 + hh * 192, 1536, p.kn() + (size_t)b * S * 1024 + hh * 128, 1024, 128, p.kr() + (size_t)b * S * 64, 64,
                         p.vt1() + (size_t)(b * 8 + hh) * 128 * S, qt * 256, 0, qt * 4 + 3, 0.07216878364870322f * LOG2E, -1e30f, 0.f, 0, smem, O, ls);
  const size_t tok = (size_t)b * S + qt * 256 + 32 * w + l32;
  const float inv = 1.f / ls[0];
#pragma unroll
  for (int db = 0; db < 4; ++db) attn_store_gated(p.h() + tok * D + hh * 128, p.z() + tok * LDZ1 + 1280 + hh * 128, O[0][db], inv, db, g);
}
DI void diff_item(const Params& p, int b, int hh, int qt, float lam, char* smem) {
  const int tid_ = otid(), lane = tid_ & 63, w = tid_ >> 6, l32 = lane & 31, g = lane >> 5;
  f32x16 O[1][4]; float ls[1];
  const bf16_t* zb = p.z() + (size_t)b * S * LDZ1;
  const bf16_t* vt = p.vtd() + (size_t)(b * 8 + hh) * 128 * S;
  f32x4* park = (f32x4*)(p.park() + ((size_t)blockIdx.x * NTH + tid_) * 64);
  attn_core<64, 1, 128>(zb + 2304 + hh * 128, LDZ1, zb + 3328 + hh * 128, LDZ1, 64, nullptr, 0, vt, qt * 256, 0, qt * 4 + 3, 0.125f * LOG2E, -1e30f, 0.f, 0, smem, O, ls);
  {
    const float i0 = 1.f / ls[0];
#pragma unroll
    for (int db = 0; db < 4; ++db)
#pragma unroll
      for (int j = 0; j < 4; ++j) { f32x4 v = {O[0][db][4 * j] * i0, O[0][db][4 * j + 1] * i0, O[0][db][4 * j + 2] * i0, O[0][db][4 * j + 3] * i0}; park[db * 4 + j] = v; }
  }
  attn_core<64, 1, 128>(zb + 2304 + hh * 128 + 64, LDZ1, zb + 3328 + hh * 128 + 64, LDZ1, 64, nullptr, 0, vt, qt * 256, 0, qt * 4 + 3, 0.125f * LOG2E, -1e30f, 0.f, 0, smem, O, ls);
  const size_t tok = (size_t)b * S + qt * 256 + 32 * w + l32;
  const float i1 = lam / ls[0];
  float ss = 0.f;
#pragma unroll
  for (int db = 0; db < 4; ++db)
#pragma unroll
    for (int j = 0; j < 4; ++j) {
      const f32x4 pv = park[db * 4 + j];
#pragma unroll
      for (int i = 0; i < 4; ++i) { const float od = pv[i] - O[0][db][4 * j + i] * i1; O[0][db][4 * j + i] = od; ss += od * od; }
    }
  ss += __shfl_xor(ss, 32);
  const float rstd = rsqrtf(ss * (1.f / 128.f) + EPS) * (1.f - LAMBDA_INIT);
  const float* slp = p.subln; asm volatile("" : "+s"(slp));
  bf16_t* yrow = p.h() + tok * D + 1024 + hh * 128;
  const bf16_t* grow = p.z() + tok * LDZ1 + 5376 + hh * 128;
#pragma unroll
  for (int db = 0; db < 4; ++db)
#pragma unroll
    for (int j = 0; j < 4; ++j) {
      const int dv = 32 * db + 8 * j + 4 * g;
      const u32x2 gr = *(const u32x2*)(grow + dv);
      const f32x4 sl = *(const f32x4*)(slp + dv);
      store_bf4(yrow + dv, O[0][db][4 * j] * rstd * sl[0] * siluf_(bflo(gr.x)), O[0][db][4 * j + 1] * rstd * sl[1] * siluf_(bfhi(gr.x)),
                O[0][db][4 * j + 2] * rstd * sl[2] * siluf_(bflo(gr.y)), O[0][db][4 * j + 3] * rstd * sl[3] * siluf_(bfhi(gr.y)));
    }
}
DI void phase_swa(const Params& p, char* smem) {
  for (int it = blockIdx.x; it < NBATCH * 16 * 16; it += gridDim.x) swa_item(p, it, smem);
}
DI void phase_attn1(const Params& p, char* smem) {
  const int G = gridDim.x;
  for (int round = 0; round * G < 512; ++round) {
    const int j = (round & 1) ? (G - 1 - (int)blockIdx.x) : (int)blockIdx.x;
    const int t = round * G + j;
    if (t >= 512) continue;
    const int qt = 15 - (t >> 5), bh = t & 31;
    mla_item(p, bh >> 3, bh & 7, qt, smem);
  }
  const float lam = diff_lambda(p);
  for (int round = 0; round * G < 512; ++round) {
    const int j = (round & 1) ? (G - 1 - (int)blockIdx.x) : (int)blockIdx.x;
    const int t = round * G + j;
    if (t >= 512) continue;
    const int qt = 15 - (t >> 5), bh = t & 31;
    diff_item(p, bh >> 3, bh & 7, qt, lam, smem);
  }
}

#define XB_TMO      128
#define XB_XCNT(j)  (256  + 64 * (j))
#define XB_XSUB(j)  (1280 + 64 * (j))
#define XB_XGEN(j)  (2304 + 64 * (j))
#define XB_TOP      3328
#define XB_TOPGEN   3392
#define XCD_BAR_WORDS 3456
#define XB_SPIN_CAP (1u << 18)
#define LAS __attribute__((address_space(3)))

__device__ __forceinline__ unsigned xb_ld(unsigned* p)              { return __hip_atomic_load(p, __ATOMIC_RELAXED, __HIP_MEMORY_SCOPE_AGENT); }
__device__ __forceinline__ unsigned xb_add(unsigned* p, unsigned v) { return __hip_atomic_fetch_add(p, v, __ATOMIC_RELAXED, __HIP_MEMORY_SCOPE_AGENT); }
__device__ __forceinline__ unsigned xb_xcc_id() { return (unsigned)__builtin_amdgcn_s_getreg((3 << 11) | 20) & 0xFu; }
#define XB_SPIN(cond, bar) do { unsigned _sp = 0; while (cond) { __builtin_amdgcn_s_sleep(1); \
    if ((++_sp & 255u) == 0u) { if (xb_ld(&(bar)[XB_TMO])) break; if (_sp > XB_SPIN_CAP) { atomicAdd(&(bar)[XB_TMO], 1u); break; } } } } while (0)

struct XcdBarrier {
    unsigned* bar; unsigned x;
    volatile LAS unsigned* st;
};

__device__ __forceinline__ XcdBarrier xcd_barrier_post(unsigned* bar, volatile LAS unsigned* st) {
    XcdBarrier b; b.bar = bar; b.x = xb_xcc_id(); b.st = st;
    if (threadIdx.x == 0) (void)xb_add(&bar[XB_XCNT(b.x)], 1u);
    return b;
}
__device__ __forceinline__ void xcd_barrier_complete(unsigned* bar, unsigned x, unsigned& nloc, unsigned& nx) {
    const unsigned G = gridDim.x * gridDim.y * gridDim.z;
    unsigned sum, cnt, mine, sp = 0u;
    for (;;) {
        sum = 0u; cnt = 0u; mine = 0u;
#pragma unroll
        for (unsigned j = 0; j < 16; ++j) { const unsigned c = xb_ld(&bar[XB_XCNT(j)]); sum += c; cnt += (c > 0u) ? 1u : 0u; mine = (j == x) ? c : mine; }
        if (sum == G) break;
        __builtin_amdgcn_s_sleep(1);
        if ((++sp & 255u) == 0u) { if (xb_ld(&bar[XB_TMO])) break; if (sp > XB_SPIN_CAP) { atomicAdd(&bar[XB_TMO], 1u); break; } }
    }
    nloc = mine > 0u ? mine : 1u; nx = cnt > 0u ? cnt : 1u;
}

__device__ __forceinline__ void xcd_barrier(const XcdBarrier& b) {
    asm volatile("s_waitcnt vmcnt(0)" ::: "memory");
    __syncthreads();
    if (threadIdx.x == 0) {
        unsigned* bar = b.bar;
        __builtin_amdgcn_s_waitcnt(0);
        unsigned nloc = b.st[0], nx = b.st[1];
        if (nloc == 0u) { xcd_barrier_complete(bar, b.x, nloc, nx); b.st[0] = nloc; b.st[1] = nx; }
        const unsigned old = xb_add(&bar[XB_XSUB(b.x)], 1u);
        const unsigned gen = old / nloc;
        if (old + 1u == (gen + 1u) * nloc) {
            __builtin_amdgcn_fence(__ATOMIC_RELEASE, "agent");
            asm volatile("s_waitcnt vmcnt(0)" ::: "memory");
            const unsigned og = xb_add(&bar[XB_TOP], 1u);
            const unsigned tg = og / nx;
            if (og + 1u == (tg + 1u) * nx) xb_add(&bar[XB_TOPGEN], 1u);
            else XB_SPIN(xb_ld(&bar[XB_TOPGEN]) == tg, bar);
            __builtin_amdgcn_fence(__ATOMIC_ACQUIRE, "agent");
            xb_add(&bar[XB_XGEN(b.x)], 1u);
            asm volatile("s_waitcnt vmcnt(0)" ::: "memory");
        } else {
            XB_SPIN(xb_ld(&bar[XB_XGEN(b.x)]) == gen, bar);
            __builtin_amdgcn_fence(__ATOMIC_ACQUIRE, "agent");
            asm volatile("s_waitcnt vmcnt(0)" ::: "memory");
        }
    }
    __syncthreads();
}

DI void gbar(unsigned* ctr, unsigned& epoch) {
  asm volatile("s_waitcnt vmcnt(0)" ::: "memory");
  __syncthreads();
  if (threadIdx.x == 0) {
    __builtin_amdgcn_fence(__ATOMIC_RELEASE, "agent");
    asm volatile("s_waitcnt vmcnt(0)" ::: "memory");
    __hip_atomic_fetch_add(ctr, 1u, __ATOMIC_RELAXED, __HIP_MEMORY_SCOPE_AGENT);
    const unsigned target = (epoch + 1u) * gridDim.x;
    while (__hip_atomic_load(ctr, __ATOMIC_RELAXED, __HIP_MEMORY_SCOPE_AGENT) < target) __builtin_amdgcn_s_sleep(2);
    __builtin_amdgcn_fence(__ATOMIC_ACQUIRE, "agent");
    asm volatile("s_waitcnt vmcnt(0)" ::: "memory");
  }
  __syncthreads();
  ++epoch;
}

constexpr int NPHASE = 13;
template <int PH>
DI void run_phase(const Params& p, char* smem) {
  if (PH == 0) { prep_weights(p, smem); rmsnorm_phase(p.x, p.norm_gains, p.h(), nullptr); }
  else if (PH == 1) phase_gemm_in0(p, smem);
  else if (PH == 2) { phase_conv(p); phase_swa(p, smem); }
  else if (PH == 3) phase_gates(p, smem);
  else if (PH == 4) phase_scan_local(p);
  else if (PH == 5) phase_scan_fix(p);
  else if (PH == 6) phase_gemm_out(p, smem, p.wt_out0(), p.x, p.out);
  else if (PH == 7) rmsnorm_phase(p.out, p.norm_gains + D, p.h(), nullptr);
  else if (PH == 8) phase_gemm_in1(p, smem);
  else if (PH == 9) phase_up(p, smem);
  else if (PH == 10) phase_attn1(p, smem);
  else if (PH == 11) phase_gemm_out(p, smem, p.wt_out1(), p.out, p.out);
  else if (PH == 12) rmsnorm_phase(p.out, p.final_gain, nullptr, p.out);
}

#if !MEGA
template <int PH>
__global__ void __launch_bounds__(NTH, 2) phase_kernel(Params p) {
  extern __shared__ __attribute__((aligned(16))) char smem[];
  run_phase<PH>(p, smem);
}

#else
__global__ void __launch_bounds__(NTH, 2) mega_kernel(Params p) {
  extern __shared__ __attribute__((aligned(16))) char smem[];
  cg::grid_group grid = cg::this_grid();
  __shared__ __attribute__((aligned(16))) unsigned xb_st[4];
  if (threadIdx.x < 4) xb_st[threadIdx.x] = 0u;
  __syncthreads();
  const XcdBarrier xb = xcd_barrier_post(p.bar(), (volatile LAS unsigned*)xb_st);
  unsigned epoch = 0;
  run_phase<0>(p, smem); grid.sync();
  run_phase<1>(p, smem); xcd_barrier(xb);
  run_phase<2>(p, smem); xcd_barrier(xb);
  run_phase<3>(p, smem); xcd_barrier(xb);
  run_phase<4>(p, smem); xcd_barrier(xb);
  run_phase<5>(p, smem); xcd_barrier(xb);
  run_phase<6>(p, smem); xcd_barrier(xb);
  run_phase<7>(p, smem); xcd_barrier(xb);
  run_phase<8>(p, smem); xcd_barrier(xb);
  run_phase<9>(p, smem); xcd_barrier(xb);
  run_phase<10>(p, smem); xcd_barrier(xb);
  run_phase<11>(p, smem); xcd_barrier(xb);
  run_phase<12>(p, smem);
}

#endif
#if !MEGA
template <int PH> static void launch_phase(const Params& p, hipStream_t st) {
  (void)hipFuncSetAttribute((const void*)phase_kernel<PH>, hipFuncAttributeMaxDynamicSharedMemorySize, SMEM_BYTES);
  hipLaunchKernelGGL(phase_kernel<PH>, dim3(256), dim3(NTH), SMEM_BYTES, st, p);
}
#endif

extern "C" void kernel_launch(void* const* d_in, const int* in_sizes, int n_in, void* d_out, int out_size, void* d_ws, size_t ws_size, hipStream_t stream) {
  Params p{};
  const float* const* in = (const float* const*)d_in;
  p.x = in[0]; p.norm_gains = in[1]; p.final_gain = in[2];
  p.w_in0 = in[3]; p.conv_w = in[4]; p.conv_b = in[5]; p.gx_w = in[6]; p.gx_b = in[7]; p.ga_w = in[8]; p.ga_b = in[9]; p.lru_lambda = in[10]; p.sinks = in[11]; p.w_out0 = in[12];
  p.w_in1 = in[13]; p.q_norm = in[14]; p.w_uq = in[15]; p.kv_norm = in[16]; p.w_ukv = in[17]; p.lq1 = in[18]; p.lk1 = in[19]; p.lq2 = in[20]; p.lk2 = in[21]; p.subln = in[22]; p.w_out1 = in[23];
  p.out = (float*)d_out;
  p.ws = (char*)d_ws;
  const size_t off = WS_NEEDED;
  if (off > ws_size) { fprintf(stderr, "workspace too small: need %zu have %zu\n", off, ws_size); return; }
#if MEGA
  static int grid_blocks = 0;
  if (!grid_blocks) {
    int dev = 0, cus = 0, per_cu = 0;
    (void)hipGetDevice(&dev);
    (void)hipDeviceGetAttribute(&cus, hipDeviceAttributeMultiprocessorCount, dev);
    (void)hipFuncSetAttribute((const void*)mega_kernel, hipFuncAttributeMaxDynamicSharedMemorySize, SMEM_BYTES);
    (void)hipOccupancyMaxActiveBlocksPerMultiprocessor(&per_cu, mega_kernel, NTH, SMEM_BYTES);
    if (per_cu > 1) per_cu = 1;
    grid_blocks = cus * per_cu;
  }
  (void)hipMemsetAsync(p.ws + OFF_BAR, 0, XCD_BAR_WORDS * 4, stream);
  void* args[] = {&p};
  hipError_t e = hipLaunchCooperativeKernel((void*)mega_kernel, dim3(grid_blocks), dim3(NTH), args, SMEM_BYTES, stream);
  if (e != hipSuccess) fprintf(stderr, "cooperative launch failed: %s (grid %d)\n", hipGetErrorString(e), grid_blocks);
#else
  launch_phase<0>(p, stream); launch_phase<1>(p, stream); launch_phase<2>(p, stream); launch_phase<3>(p, stream);
  launch_phase<4>(p, stream); launch_phase<5>(p, stream); launch_phase<6>(p, stream); launch_phase<7>(p, stream);
  launch_phase<8>(p, stream); launch_phase<9>(p, stream); launch_phase<10>(p, stream); launch_phase<11>(p, stream);
  launch_phase<12>(p, stream);
#endif
}
```

```cpp
#include <hip/hip_runtime.h>
#include <hip/hip_cooperative_groups.h>
#include <cstdio>
#include <cstdint>
namespace cg = cooperative_groups;

#ifndef MEGA
#define MEGA 1
#endif
#ifndef NAIVE_ATTN
#define NAIVE_ATTN 0
#endif

#define DI __device__ __forceinline__
typedef unsigned short bf16_t;
typedef short bf16x8 __attribute__((ext_vector_type(8)));
typedef float f32x16 __attribute__((ext_vector_type(16)));
typedef float f32x4 __attribute__((ext_vector_type(4)));
typedef float f32x2 __attribute__((ext_vector_type(2)));
typedef unsigned u32x4 __attribute__((ext_vector_type(4)));
typedef unsigned u32x2 __attribute__((ext_vector_type(2)));
typedef __bf16 bf2_t __attribute__((ext_vector_type(2)));

constexpr int T = 16384, S = 4096, NBATCH = 4, D = 2048;
constexpr int NTH = 512, NWV = 8;
constexpr int LDZ0 = 4352, LDZ1 = 6528, NPAD1 = 6656;
constexpr float EPS = 1e-6f;
constexpr float LOG2E = 1.4426950408889634f;
constexpr float LAMBDA_INIT = 0.35550906759096927f;

constexpr size_t al256(size_t b) { return (b + 255) & ~(size_t)255; }
constexpr size_t OFF_WT_IN0 = 0;
constexpr size_t OFF_WT_OUT0 = OFF_WT_IN0 + al256((size_t)4352 * 2048 * 2);
constexpr size_t OFF_WT_G = OFF_WT_OUT0 + al256((size_t)2048 * 2048 * 2);
constexpr size_t OFF_WT_IN1 = OFF_WT_G + al256((size_t)2048 * 128 * 2);
constexpr size_t OFF_WT_UQ = OFF_WT_IN1 + al256((size_t)NPAD1 * 2048 * 2);
constexpr size_t OFF_WT_UKV = OFF_WT_UQ + al256((size_t)1536 * 768 * 2);
constexpr size_t OFF_WT_OUT1 = OFF_WT_UKV + al256((size_t)2048 * 512 * 2);
constexpr size_t OFF_ROPE = OFF_WT_OUT1 + al256((size_t)2048 * 2048 * 2);
constexpr size_t OFF_H = OFF_ROPE + al256((size_t)4096 * 32 * 2 * 4);
constexpr size_t OFF_Z = OFF_H + al256((size_t)T * 2048 * 2);
constexpr size_t OFF_CARRY = OFF_Z + al256((size_t)T * LDZ1 * 2);
constexpr size_t OFF_VT0 = OFF_CARRY + al256((size_t)2 * NBATCH * 128 * 1024 * 4);
constexpr size_t OFF_Q1 = OFF_VT0 + al256((size_t)NBATCH * 2 * 64 * S * 2);
constexpr size_t OFF_KN = OFF_Q1 + al256((size_t)T * 1536 * 2);
constexpr size_t OFF_KR = OFF_KN + al256((size_t)T * 1024 * 2);
constexpr size_t OFF_VT1 = OFF_KR + al256((size_t)T * 64 * 2);
constexpr size_t OFF_VTD = OFF_VT1 + al256((size_t)T * 1024 * 2);
constexpr size_t OFF_CF = OFF_VTD + al256((size_t)T * 1024 * 2);
constexpr size_t OFF_BAR = OFF_CF + 4096;
constexpr size_t WS_NEEDED = OFF_BAR + 16384;

struct Params {
  const float *x, *norm_gains, *final_gain;
  const float *w_in0, *conv_w, *conv_b, *gx_w, *gx_b, *ga_w, *ga_b, *lru_lambda, *sinks, *w_out0;
  const float *w_in1, *q_norm, *w_uq, *kv_norm, *w_ukv, *lq1, *lk1, *lq2, *lk2, *subln, *w_out1;
  float* out;
  char* ws;
  DI bf16_t* wt_in0() const { return (bf16_t*)(ws + OFF_WT_IN0); }
  DI bf16_t* wt_out0() const { return (bf16_t*)(ws + OFF_WT_OUT0); }
  DI bf16_t* wt_g() const { return (bf16_t*)(ws + OFF_WT_G); }
  DI bf16_t* wt_in1() const { return (bf16_t*)(ws + OFF_WT_IN1); }
  DI bf16_t* wt_uq() const { return (bf16_t*)(ws + OFF_WT_UQ); }
  DI bf16_t* wt_ukv() const { return (bf16_t*)(ws + OFF_WT_UKV); }
  DI bf16_t* wt_out1() const { return (bf16_t*)(ws + OFF_WT_OUT1); }
  DI float* rope() const { return (float*)(ws + OFF_ROPE); }
  DI bf16_t* h() const { return (bf16_t*)(ws + OFF_H); }
  DI bf16_t* z() const { return (bf16_t*)(ws + OFF_Z); }
  DI bf16_t* xc() const { return (bf16_t*)(ws + OFF_Q1); }
  DI float* carry() const { return (float*)(ws + OFF_CARRY); }
  DI bf16_t* vt0() const { return (bf16_t*)(ws + OFF_VT0); }
  DI bf16_t* q1() const { return (bf16_t*)(ws + OFF_Q1); }
  DI bf16_t* kn() const { return (bf16_t*)(ws + OFF_KN); }
  DI bf16_t* kr() const { return (bf16_t*)(ws + OFF_KR); }
  DI bf16_t* vt1() const { return (bf16_t*)(ws + OFF_VT1); }
  DI bf16_t* vtd() const { return (bf16_t*)(ws + OFF_VTD); }
  DI float* cf() const { return (float*)(ws + OFF_CF); }
  DI unsigned* bar() const { return (unsigned*)(ws + OFF_BAR); }
  DI float* park() const { return (float*)ws; }
  DI float* av() const { return out; }
  DI float* uv() const { return out + (size_t)T * 1024; }
};

DI unsigned pk_bf16(float lo, float hi) {
  f32x2 v = {lo, hi};
  bf2_t r = __builtin_convertvector(v, bf2_t);
  return __builtin_bit_cast(unsigned, r);
}
DI bf16_t f2bf(float f) { return (bf16_t)(pk_bf16(f, 0.f) & 0xffffu); }
DI float bf2f(bf16_t v) { return __uint_as_float(((unsigned)v) << 16); }
DI float bflo(unsigned u) { return __uint_as_float(u << 16); }
DI float bfhi(unsigned u) { return __uint_as_float(u & 0xffff0000u); }
DI int otid() { int t = threadIdx.x; asm volatile("" : "+v"(t)); return t; }
DI float sigmoidf_(float v) { return 1.f / (1.f + __expf(-v)); }
DI float siluf_(float v) { return v / (1.f + __expf(-v)); }
DI float wave_sum(float v) {
#pragma unroll
  for (int o = 32; o > 0; o >>= 1) v += __shfl_xor(v, o);
  return v;
}
DI float wave_max(float v) {
#pragma unroll
  for (int o = 32; o > 0; o >>= 1) v = fmaxf(v, __shfl_xor(v, o));
  return v;
}

struct TJob { const float* W; int nsrc, src_col0; bf16_t* Wt; int K, dst_row0, k0; const float* kscale; int nvalid; bool valid; };
constexpr int TP = 132;
DI void transpose_tile(const TJob& j, int tid, float* lds  ) {
  __syncthreads();
  if (j.valid) {
    const int n4 = (tid & 31) * 4, kb = tid >> 5;
    f32x4 v[8];
#pragma unroll
    for (int i = 0; i < 8; ++i) {
      const int kk = kb + 8 * i;
      v[i] = (n4 < j.nvalid) ? *(const f32x4*)(j.W + (size_t)(j.k0 + kk) * j.nsrc + j.src_col0 + n4) : (f32x4){0.f, 0.f, 0.f, 0.f};
    }
#pragma unroll
    for (int i = 0; i < 8; ++i) {
      const int kk = kb + 8 * i;
      if (j.kscale) v[i] *= j.kscale[j.k0 + kk];
      *(f32x4*)(lds + kk * TP + n4) = v[i];
    }
  }
  __syncthreads();
  if (j.valid) {
    const int n = tid >> 1, kh = (tid & 1) * 32;
    bf16_t* dst = j.Wt + (size_t)(j.dst_row0 + n) * j.K + j.k0 + kh;
#pragma unroll
    for (int q = 0; q < 4; ++q) {
      u32x4 o;
      o.x = pk_bf16(lds[(kh + q * 8 + 0) * TP + n], lds[(kh + q * 8 + 1) * TP + n]);
      o.y = pk_bf16(lds[(kh + q * 8 + 2) * TP + n], lds[(kh + q * 8 + 3) * TP + n]);
      o.z = pk_bf16(lds[(kh + q * 8 + 4) * TP + n], lds[(kh + q * 8 + 5) * TP + n]);
      o.w = pk_bf16(lds[(kh + q * 8 + 6) * TP + n], lds[(kh + q * 8 + 7) * TP + n]);
      *(u32x4*)(dst + q * 8) = o;
    }
  }
}

DI void prep_weights(const Params& p, char* smem) {
  const int half = threadIdx.x >> 8, tid = threadIdx.x & 255;
  float* lds = (float*)smem + half * (64 * TP);
  constexpr int J0 = 34 * 32, J1 = 16 * 32, J3 = 52 * 32, J4 = 12 * 12, J5 = 16 * 8, J6 = 16 * 32;
  constexpr int TOT = J0 + J1 + J3 + J4 + J5 + J6;
  for (int t0 = blockIdx.x * 2; t0 < TOT; t0 += gridDim.x * 2) {
    const int t = t0 + half;
    TJob j{}; j.valid = t < TOT;
    int u = t;
    if (!j.valid) { }
    else if (u < J0) { const int nt = u / 32, kt = u % 32; j = TJob{p.w_in0, 4352, nt * 128, p.wt_in0(), 2048, nt * 128, kt * 64, nullptr, 128, true}; }
    else if ((u -= J0) < J1) { const int nt = u / 32, kt = u % 32; j = TJob{p.w_out0, 2048, nt * 128, p.wt_out0(), 2048, nt * 128, kt * 64, nullptr, 128, true}; }
    else if ((u -= J1) < J3) {
      const int nt = u / 32, kt = u % 32; const int r = nt * 128;
      int sc, nv = 128;
      if (r < 1280) sc = r; else if (r < 6400) sc = r + 64; else if (r < 6464) { sc = r - 6400 + 1280; nv = 64; } else { sc = 0; nv = 0; }
      j = TJob{p.w_in1, 6464, sc, p.wt_in1(), 2048, r, kt * 64, nullptr, nv, true};
    }
    else if ((u -= J3) < J4) { const int nt = u / 12, kt = u % 12; j = TJob{p.w_uq, 1536, nt * 128, p.wt_uq(), 768, nt * 128, kt * 64, p.q_norm, 128, true}; }
    else if ((u -= J4) < J5) { const int nt = u / 8, kt = u % 8; j = TJob{p.w_ukv, 2048, nt * 128, p.wt_ukv(), 512, nt * 128, kt * 64, p.kv_norm, 128, true}; }
    else { u -= J5; const int nt = u / 32, kt = u % 32; j = TJob{p.w_out1, 2048, nt * 128, p.wt_out1(), 2048, nt * 128, kt * 64, nullptr, 128, true}; }
    transpose_tile(j, tid, lds);
  }
  for (int i = blockIdx.x * NTH + otid(); i < 2048 * 16; i += gridDim.x * NTH) {
    const int r = i >> 4, d0 = (i & 15) * 8, gi = r >> 8, nl = r & 255, c32 = nl >> 6, which = (nl >> 5) & 1, e = c32 * 32 + (nl & 31);
    const float* src = (which ? p.ga_w : p.gx_w) + (size_t)gi * 128 * 128 + e;
    u32x4 o;
    o.x = pk_bf16(src[(d0 + 0) * 128], src[(d0 + 1) * 128]); o.y = pk_bf16(src[(d0 + 2) * 128], src[(d0 + 3) * 128]);
    o.z = pk_bf16(src[(d0 + 4) * 128], src[(d0 + 5) * 128]); o.w = pk_bf16(src[(d0 + 6) * 128], src[(d0 + 7) * 128]);
    *(u32x4*)(p.wt_g() + (size_t)r * 128 + d0) = o;
  }
  for (int i = blockIdx.x * NTH + otid(); i < 1024; i += gridDim.x * NTH) {
    const float nl = -p.lru_lambda[i];
    p.cf()[i] = -8.0f * (fmaxf(nl, 0.f) + log1pf(__expf(-fabsf(nl))));
  }
  for (int i = blockIdx.x * NTH + otid(); i < 4096 * 32; i += gridDim.x * NTH) {
    const int pos = i >> 5, fi = i & 31;
    const float freq = exp2f(-(float)fi * (13.287712379549449f / 32.f));
    double rev = (double)pos * (double)freq * 0.15915494309189535;
    rev -= floor(rev);
    const float rv = (float)rev;
    p.rope()[2 * i] = __builtin_amdgcn_cosf(rv);
    p.rope()[2 * i + 1] = __builtin_amdgcn_sinf(rv);
  }
}

DI void rmsnorm_phase(const float* __restrict__ X, const float* __restrict__ g, bf16_t* __restrict__ H, float* __restrict__ OF) {
  const int tid = otid(), lane = tid & 63;
  const int gw = blockIdx.x * NWV + (tid >> 6), nw = gridDim.x * NWV;
  for (int row = gw; row < T; row += nw) {
    const float* xr = X + (size_t)row * D;
    f32x4 v[8];
    float ss = 0.f;
#pragma unroll
    for (int i = 0; i < 8; ++i) { v[i] = *(const f32x4*)(xr + lane * 4 + 256 * i); ss += v[i][0] * v[i][0] + v[i][1] * v[i][1] + v[i][2] * v[i][2] + v[i][3] * v[i][3]; }
    ss = wave_sum(ss);
    const float rstd = rsqrtf(ss * (1.f / D) + EPS);
#pragma unroll
    for (int i = 0; i < 8; ++i) {
      const f32x4 gg = *(const f32x4*)(g + lane * 4 + 256 * i);
      f32x4 o = v[i] * rstd * gg;
      if (H) { u32x2 w; w.x = pk_bf16(o[0], o[1]); w.y = pk_bf16(o[2], o[3]); *(u32x2*)(H + (size_t)row * D + lane * 4 + 256 * i) = w; }
      else *(f32x4*)(OF + (size_t)row * D + lane * 4 + 256 * i) = o;
    }
  }
}

constexpr int GS = 72;
constexpr int G_TILE_EL = 256 * GS;
constexpr int G_STAGE_EL = 2 * G_TILE_EL;
constexpr int G_BYTES = 2 * G_STAGE_EL * 2;
constexpr int G_RSTD_OFF = G_BYTES;
constexpr int SMEM_BYTES = G_BYTES + 1024;

struct GTile { const bf16_t* A; int lda; const bf16_t* Bt; int ldb; int K, m0, n0; };
template <bool trans>
DI void gemm_core(const GTile& tl, const GTile& nx, bool has_next  , bool chain  , bool pre, u32x4 (&ra)[4], u32x4 (&rb)[4], char* smem, f32x16 (&acc)[2][4]) {
  const bf16_t* __restrict__ A = tl.A; const bf16_t* __restrict__ Bt = tl.Bt; const int lda = tl.lda, ldb = tl.ldb, K = tl.K, m0 = tl.m0, n0 = tl.n0;
  bf16_t* lds = (bf16_t*)smem;
  const int tid = otid(), lane = tid & 63, w = __builtin_amdgcn_readfirstlane(tid >> 6), wm = w >> 2, wn = w & 3, l32 = lane & 31, g = lane >> 5;
#pragma unroll
  for (int a = 0; a < 2; ++a)
#pragma unroll
    for (int b = 0; b < 4; ++b)
#pragma unroll
      for (int r = 0; r < 16; ++r) acc[a][b][r] = 0.f;
  const int lrow = tid >> 3, kc = tid & 7;
  const unsigned aoff = (unsigned)(lrow * lda + kc * 8) * 2u, boff = (unsigned)(lrow * ldb + kc * 8) * 2u;
  const char* ag = (const char*)(A + (size_t)m0 * lda);
  const char* bg = (const char*)(Bt + (size_t)n0 * ldb);
  const unsigned aoffn = (unsigned)(lrow * nx.lda + kc * 8) * 2u, boffn = (unsigned)(lrow * nx.ldb + kc * 8) * 2u;
  const char* agn = (const char*)(nx.A + (size_t)nx.m0 * nx.lda);
  const char* bgn = (const char*)(nx.Bt + (size_t)nx.n0 * nx.ldb);
#define G_LOAD(KT)                                                                                                 \
  {                                                                                                                \
    const int ko = (KT) * 64;                                                                                      \
    _Pragma("unroll") for (int i = 0; i < 4; ++i) ra[i] = *(const u32x4*)(ag + ((size_t)(64 * i) * lda + ko) * 2 + aoff); \
    _Pragma("unroll") for (int i = 0; i < 4; ++i) rb[i] = *(const u32x4*)(bg + ((size_t)(64 * i) * ldb + ko) * 2 + boff); \
  }
#define G_STORE(ST)                                                                                                \
  {                                                                                                                \
    bf16_t* la = lds + (ST) * G_STAGE_EL + lrow * GS + kc * 8;                                                     \
    _Pragma("unroll") for (int i = 0; i < 4; ++i) *(u32x4*)(la + 64 * i * GS) = ra[i];                             \
    _Pragma("unroll") for (int i = 0; i < 4; ++i) *(u32x4*)(la + G_TILE_EL + 64 * i * GS) = rb[i];                 \
  }
#define G_AF(KS, MB) (*(const bf16x8*)(ca + (MB) * 32 * GS + (KS) * 16))
#define G_M2(AF, MB)                                                                                               \
  {                                                                                                                \
    if (trans) { acc[0][MB] = __builtin_amdgcn_mfma_f32_32x32x16_bf16(AF, b0, acc[0][MB], 0, 0, 0);                \
                 acc[1][MB] = __builtin_amdgcn_mfma_f32_32x32x16_bf16(AF, b1, acc[1][MB], 0, 0, 0); }              \
    else { acc[0][MB] = __builtin_amdgcn_mfma_f32_32x32x16_bf16(b0, AF, acc[0][MB], 0, 0, 0);                      \
           acc[1][MB] = __builtin_amdgcn_mfma_f32_32x32x16_bf16(b1, AF, acc[1][MB], 0, 0, 0); }                    \
  }
#define G_KSTEP(KS)                                                                                                \
  {                                                                                                                \
    const bf16x8 b0 = *(const bf16x8*)(cb + (KS) * 16), b1 = *(const bf16x8*)(cb + 32 * GS + (KS) * 16);           \
    bf16x8 a0 = G_AF(KS, 0), a1 = G_AF(KS, 1);                                                                     \
    __builtin_amdgcn_s_setprio(1);     \
    G_M2(a0, 0); a0 = G_AF(KS, 2);                                                                                 \
    G_M2(a1, 1); a1 = G_AF(KS, 3);                                                                                 \
    G_M2(a0, 2);                                                                                                   \
    G_M2(a1, 3);                                                                                                   \
    __builtin_amdgcn_s_setprio(0);                                                                                 \
  }
#define G_PART(I, KT)                                                                                              \
  {                                                                                                                \
    if (do_store) {                                                                                                \
      bf16_t* la = lds + nst * G_STAGE_EL + lrow * GS + kc * 8;                                                    \
      *(u32x4*)(la + 64 * (I) * GS) = ra[I];                                                                       \
      *(u32x4*)(la + G_TILE_EL + 64 * (I) * GS) = rb[I];                                                           \
    }                                                                                                              \
    if (do_load) {                                                                                                 \
      const int ko = ((KT) + 2) * 64;                                                                              \
      ra[I] = *(const u32x4*)(ag + ((size_t)(64 * (I)) * lda + ko) * 2 + aoff);                                    \
      rb[I] = *(const u32x4*)(bg + ((size_t)(64 * (I)) * ldb + ko) * 2 + boff);                                    \
    } else if (chain) {                                                                                            \
      const int ko = ((KT) + 2 - nk) * 64;                                                                         \
      ra[I] = *(const u32x4*)(agn + ((size_t)(64 * (I)) * nx.lda + ko) * 2 + aoffn);                               \
      rb[I] = *(const u32x4*)(bgn + ((size_t)(64 * (I)) * nx.ldb + ko) * 2 + boffn);                               \
    }                                                                                                              \
  }
#define G_COMPUTE(ST, KT)                                                                                          \
  {                                                                                                                \
    const bf16_t* ca = lds + (ST) * G_STAGE_EL + (wm * 128 + l32) * GS + g * 8;                                    \
    const bf16_t* cb = lds + (ST) * G_STAGE_EL + G_TILE_EL + (wn * 64 + l32) * GS + g * 8;                         \
    const int nst = (ST) ^ 1;                                                                                      \
    const bool do_store = (KT) + 1 < nk || chain, do_load = (KT) + 2 < nk;                                         \
    G_PART(0, KT); G_KSTEP(0); __builtin_amdgcn_sched_barrier(0);                                                  \
    G_PART(1, KT); G_KSTEP(1); __builtin_amdgcn_sched_barrier(0);                                                  \
    G_PART(2, KT); G_KSTEP(2); __builtin_amdgcn_sched_barrier(0);                                                  \
    G_PART(3, KT); G_KSTEP(3); __builtin_amdgcn_sched_barrier(0);                                                  \
  }
  const int nk = K / 64;
  if (!pre) { G_LOAD(0); G_STORE(0); G_LOAD(1); }
  for (int kt = 0; kt < nk; ++kt) {
    __syncthreads();
    G_COMPUTE(kt & 1, kt);
  }
  if (!has_next) __syncthreads();
#undef G_LOAD
#undef G_STORE
#undef G_COMPUTE
#undef G_AF
#undef G_M2
#undef G_KSTEP
#undef G_PART
}

DI void gemm_half_rowbf16(const bf16_t* __restrict__ A, int lda, const bf16_t* __restrict__ Bt, int ldb, int K, int m0, int n0, char* smem, bf16_t* __restrict__ Out, int ldo) {
  bf16_t* lds = (bf16_t*)smem;
  const int tid = otid(), lane = tid & 63, w = __builtin_amdgcn_readfirstlane(tid >> 6), l32 = lane & 31, g = lane >> 5;
  f32x16 acc[4];
#pragma unroll
  for (int b = 0; b < 4; ++b)
#pragma unroll
    for (int r = 0; r < 16; ++r) acc[b][r] = 0.f;
  const int lrow = tid >> 3, kc = tid & 7;
  const unsigned aoff = (unsigned)(lrow * lda + kc * 8) * 2u, boff = (unsigned)(lrow * ldb + kc * 8) * 2u;
  const char* ag = (const char*)(A + (size_t)m0 * lda);
  const char* bg = (const char*)(Bt + (size_t)n0 * ldb);
  u32x4 ra[2], rb[4];
#define H_LOADA(I, KT) ra[I] = *(const u32x4*)(ag + ((size_t)(64 * (I)) * lda + (KT) * 64) * 2 + aoff)
#define H_LOADB(I, KT) rb[I] = *(const u32x4*)(bg + ((size_t)(64 * (I)) * ldb + (KT) * 64) * 2 + boff)
#define H_STOREA(ST, I) *(u32x4*)(lds + (ST) * G_STAGE_EL + lrow * GS + kc * 8 + 64 * (I) * GS) = ra[I]
#define H_STOREB(ST, I) *(u32x4*)(lds + (ST) * G_STAGE_EL + G_TILE_EL + lrow * GS + kc * 8 + 64 * (I) * GS) = rb[I]
#define H_FRAGS(F, ST, KS)                                                                                         \
  {                                                                                                                \
    const bf16_t* ca = lds + (ST) * G_STAGE_EL + l32 * GS + g * 8 + (KS) * 16;                                     \
    _Pragma("unroll") for (int mb = 0; mb < 4; ++mb) F[mb] = *(const bf16x8*)(ca + mb * 32 * GS);                  \
    F[4] = *(const bf16x8*)(lds + (ST) * G_STAGE_EL + G_TILE_EL + (w * 32 + l32) * GS + g * 8 + (KS) * 16);        \
  }
#define H_MMA(F) { _Pragma("unroll") for (int mb = 0; mb < 4; ++mb) acc[mb] = __builtin_amdgcn_mfma_f32_32x32x16_bf16(F[4], F[mb], acc[mb], 0, 0, 0); }
#define H_PART(I, ST, KT)                                                                                          \
  {                                                                                                                \
    if ((KT) + 1 < nk) { H_STOREB((ST) ^ 1, I); if ((I) < 2) H_STOREA((ST) ^ 1, (I) & 1); }                        \
    if ((KT) + 2 < nk) { H_LOADB(I, (KT) + 2); if ((I) < 2) H_LOADA((I) & 1, (KT) + 2); }                          \
  }
  const int nk = K / 64;
  H_LOADA(0, 0); H_LOADA(1, 0); H_LOADB(0, 0); H_LOADB(1, 0); H_LOADB(2, 0); H_LOADB(3, 0);
  H_STOREA(0, 0); H_STOREA(0, 1); H_STOREB(0, 0); H_STOREB(0, 1); H_STOREB(0, 2); H_STOREB(0, 3);
  if (nk > 1) { H_LOADA(0, 1); H_LOADA(1, 1); H_LOADB(0, 1); H_LOADB(1, 1); H_LOADB(2, 1); H_LOADB(3, 1); }
  for (int kt = 0; kt < nk; ++kt) {
    const int st = kt & 1;
    __syncthreads();
    bf16x8 f0[5], f1[5];
    H_FRAGS(f0, st, 0);
    H_PART(0, st, kt); H_FRAGS(f1, st, 1); H_MMA(f0); __builtin_amdgcn_sched_barrier(0);
    H_PART(1, st, kt); H_FRAGS(f0, st, 2); H_MMA(f1); __builtin_amdgcn_sched_barrier(0);
    H_PART(2, st, kt); H_FRAGS(f1, st, 3); H_MMA(f0); __builtin_amdgcn_sched_barrier(0);
    H_PART(3, st, kt); H_MMA(f1); __builtin_amdgcn_sched_barrier(0);
  }
  __syncthreads();
#undef H_LOADA
#undef H_LOADB
#undef H_STOREA
#undef H_STOREB
#undef H_FRAGS
#undef H_MMA
#undef H_PART
#pragma unroll
  for (int mb = 0; mb < 4; ++mb) {
    const size_t tok = m0 + 32 * mb + l32;
#pragma unroll
    for (int j = 0; j < 4; ++j) {
      const int n = n0 + 32 * w + 8 * j + 4 * g;
      u32x2 wv; wv.x = pk_bf16(acc[mb][4 * j], acc[mb][4 * j + 1]); wv.y = pk_bf16(acc[mb][4 * j + 2], acc[mb][4 * j + 3]);
      *(u32x2*)(Out + tok * ldo + n) = wv;
    }
  }
}

DI void store_bf4(bf16_t* dst, float a, float b, float c, float d) { u32x2 w; w.x = pk_bf16(a, b); w.y = pk_bf16(c, d); *(u32x2*)dst = w; }

DI void store_bf8_pair(bf16_t* rowp  , int g, u32x2 a  , u32x2 b  ) {
  auto rx = __builtin_amdgcn_permlane32_swap(a.x, b.x, false, false);
  auto ry = __builtin_amdgcn_permlane32_swap(a.y, b.y, false, false);
  u32x4 v = {rx[0], ry[0], rx[1], ry[1]};
  *(u32x4*)(rowp + 8 * g) = v;
}
struct EpiRowBf16 {
  bf16_t* O; int ld;
  DI void operator()(const f32x16 (&acc)[2][4], int mbase, int nbase, int l32, int g) const {
#pragma unroll
    for (int nb = 0; nb < 2; ++nb)
#pragma unroll
      for (int mb = 0; mb < 4; ++mb) {
        const size_t tok = mbase + 32 * mb + l32;
        const f32x16& c = acc[nb][mb];
#pragma unroll
        for (int j = 0; j < 4; j += 2) {
          u32x2 a, b;
          a.x = pk_bf16(c[4 * j], c[4 * j + 1]); a.y = pk_bf16(c[4 * j + 2], c[4 * j + 3]);
          b.x = pk_bf16(c[4 * j + 4], c[4 * j + 5]); b.y = pk_bf16(c[4 * j + 6], c[4 * j + 7]);
          store_bf8_pair(O + tok * ld + nbase + 32 * nb + 8 * j, g, a, b);
        }
      }
  }
};

struct EpiVt {
  bf16_t* O; int H, DV, ncol0; const float* rs; int m0;
  DI void operator()(const f32x16 (&acc)[2][4], int mbase, int nbase, int l32, int g) const {
#pragma unroll
    for (int nb = 0; nb < 2; ++nb) {
      const int n = nbase + 32 * nb + l32 - ncol0;
      const int head = n / DV, dv = n % DV;
#pragma unroll
      for (int mb = 0; mb < 4; ++mb)
#pragma unroll
        for (int j = 0; j < 4; ++j) {
          const int tok = mbase + 32 * mb + 8 * j + 4 * g;
          const int b = tok >> 12, s = tok & 4095;
          float v0 = acc[nb][mb][4 * j], v1 = acc[nb][mb][4 * j + 1], v2 = acc[nb][mb][4 * j + 2], v3 = acc[nb][mb][4 * j + 3];
          if (rs) { const f32x4 r4 = *(const f32x4*)(rs + (tok - m0)); v0 *= r4[0]; v1 *= r4[1]; v2 *= r4[2]; v3 *= r4[3]; }
          store_bf4(O + ((size_t)(b * H + head) * DV + dv) * S + s, v0, v1, v2, v3);
        }
    }
  }
};

struct EpiResid {
  const float* R; float* O;
  DI void operator()(const f32x16 (&acc)[2][4], int mbase, int nbase, int l32, int g) const {
#pragma unroll
    for (int nb = 0; nb < 2; ++nb)
#pragma unroll
      for (int mb = 0; mb < 4; ++mb) {
        const size_t tok = mbase + 32 * mb + l32;
#pragma unroll
        for (int j = 0; j < 4; ++j) {
          const int n = nbase + 32 * nb + 8 * j + 4 * g;
          f32x4 r = *(const f32x4*)(R + tok * D + n);
          r[0] += acc[nb][mb][4 * j]; r[1] += acc[nb][mb][4 * j + 1]; r[2] += acc[nb][mb][4 * j + 2]; r[3] += acc[nb][mb][4 * j + 3];
          *(f32x4*)(O + tok * D + n) = r;
        }
      }
  }
};

struct EpiGates {
  const Params* p; int ch0;
  DI void operator()(const f32x16 (&acc)[2][4], int mbase, int nbase, int l32, int g) const {
#pragma unroll
    for (int j = 0; j < 4; ++j) {
      const int ch = ch0 + 8 * j + 4 * g;
      const f32x4 bx = *(const f32x4*)(p->gx_b + ch), ba = *(const f32x4*)(p->ga_b + ch), cf = *(const f32x4*)(p->cf() + ch);
#pragma unroll
      for (int mb = 0; mb < 4; ++mb) {
        const size_t tok = mbase + 32 * mb + l32;
        const u32x2 xr = *(const u32x2*)(p->xc() + tok * 1024 + ch);
        const float xv[4] = {bflo(xr.x), bfhi(xr.x), bflo(xr.y), bfhi(xr.y)};
        f32x4 av, uv;
#pragma unroll
        for (int i = 0; i < 4; ++i) {
          const float gi = __builtin_amdgcn_rcpf(1.f + __expf(-(acc[0][mb][4 * j + i] + bx[i])));
          const float gr = __builtin_amdgcn_rcpf(1.f + __expf(-(acc[1][mb][4 * j + i] + ba[i])));
          const float la = cf[i] * gr;
          const float x2 = 2.f * la;
          const float ser = -x2 * (1.f + x2 * (0.5f + x2 * (0.16666667f + x2 * (0.041666668f + x2 * 0.0083333333f))));
          const float m2 = (x2 > -0.3f) ? ser : (1.f - __expf(x2));
          av[i] = __expf(la);
          uv[i] = sqrtf(fmaxf(m2, 0.f)) * gi * xv[i];
        }
        *(f32x4*)(p->av() + tok * 1024 + ch) = av;
        *(f32x4*)(p->uv() + tok * 1024 + ch) = uv;
      }
    }
  }
};

struct EpiRopeK {
  const Params* p;
  DI void operator()(const f32x16 (&acc)[2][4], int mbase, int nbase, int l32, int g) const {
    if (nbase != 6400) return;
#pragma unroll
    for (int mb = 0; mb < 4; ++mb) {
      const size_t tok = mbase + 32 * mb + l32;
      const int pos = (int)(tok & 4095);
#pragma unroll
      for (int j = 0; j < 4; ++j) {
        const int i0 = 8 * j + 4 * g;
        float o1[4], o2[4];
#pragma unroll
        for (int i = 0; i < 4; ++i) {
          const f32x2 cs = *(const f32x2*)(p->rope() + ((size_t)pos * 32 + i0 + i) * 2);
          const float x1 = acc[0][mb][4 * j + i], x2 = acc[1][mb][4 * j + i];
          o1[i] = x1 * cs[0] - x2 * cs[1]; o2[i] = x1 * cs[1] + x2 * cs[0];
        }
        store_bf4(p->kr() + tok * 64 + i0, o1[0], o1[1], o1[2], o1[3]);
        store_bf4(p->kr() + tok * 64 + 32 + i0, o2[0], o2[1], o2[2], o2[3]);
      }
    }
  }
};

struct EpiQ {
  const Params* p; const float* rs; int m0;
  DI void operator()(const f32x16 (&acc)[2][4], int mbase, int nbase, int l32, int g) const {
    const bool rp = ((nbase >> 6) % 3) == 2;
#pragma unroll
    for (int mb = 0; mb < 4; ++mb) {
      const size_t tok = mbase + 32 * mb + l32;
      const float r = rs[tok - m0];
      const int pos = (int)(tok & 4095);
#pragma unroll
      for (int j = 0; j < 4; ++j) {
        const int i0 = 8 * j + 4 * g;
        float o1[4], o2[4];
#pragma unroll
        for (int i = 0; i < 4; ++i) {
          const float x1 = acc[0][mb][4 * j + i] * r, x2 = acc[1][mb][4 * j + i] * r;
          if (rp) {
            const f32x2 cs = *(const f32x2*)(p->rope() + ((size_t)pos * 32 + i0 + i) * 2);
            o1[i] = x1 * cs[0] - x2 * cs[1]; o2[i] = x1 * cs[1] + x2 * cs[0];
          } else { o1[i] = x1; o2[i] = x2; }
        }
        store_bf4(p->q1() + tok * 1536 + nbase + i0, o1[0], o1[1], o1[2], o1[3]);
        store_bf4(p->q1() + tok * 1536 + nbase + 32 + i0, o2[0], o2[1], o2[2], o2[3]);
      }
    }
  }
};

struct EpiKn {
  const Params* p; const float* rs; int m0; int head; int n0;
  DI void operator()(const f32x16 (&acc)[2][4], int mbase, int nbase, int l32, int g) const {
#pragma unroll
    for (int nb = 0; nb < 2; ++nb)
#pragma unroll
      for (int mb = 0; mb < 4; ++mb) {
        const size_t tok = mbase + 32 * mb + l32;
        const float r = rs[tok - m0];
#pragma unroll
        for (int j = 0; j < 4; ++j) {
          const int n = nbase - n0 + 32 * nb + 8 * j + 4 * g;
          store_bf4(p->kn() + tok * 1024 + head * 128 + n, acc[nb][mb][4 * j] * r, acc[nb][mb][4 * j + 1] * r, acc[nb][mb][4 * j + 2] * r, acc[nb][mb][4 * j + 3] * r);
        }
      }
  }
};

DI void row_rstd(const bf16_t* __restrict__ A, int lda, int K, int m0, float* rs) {
  const int tid = otid();
  const bf16_t* r = A + (size_t)(m0 + (tid >> 1)) * lda + (tid & 1) * (K / 2);
  float ss = 0.f;
  for (int c = 0; c < K / 2; c += 8) {
    const u32x4 v = *(const u32x4*)(r + c);
    ss += bflo(v.x) * bflo(v.x) + bfhi(v.x) * bfhi(v.x) + bflo(v.y) * bflo(v.y) + bfhi(v.y) * bfhi(v.y) +
          bflo(v.z) * bflo(v.z) + bfhi(v.z) * bfhi(v.z) + bflo(v.w) * bflo(v.w) + bfhi(v.w) * bfhi(v.w);
  }
  ss += __shfl_xor(ss, 1);
  if ((tid & 1) == 0) rs[tid >> 1] = rsqrtf(ss / (float)K + EPS);
  __syncthreads();
}

#define WAVE_GEOM const int tid_ = otid(), w_ = __builtin_amdgcn_readfirstlane(tid_ >> 6), wm_ = w_ >> 2, wn_ = w_ & 3, l32_ = tid_ & 31, g_ = (tid_ >> 5) & 1
DI void phase_gemm_in0(const Params& p, char* smem) {
  u32x4 ra[4], rb[4]; bool pre = false;
  for (int t = blockIdx.x; t < 64 * 16; t += gridDim.x) {
    const int mt = t & 63, nt = t >> 6, tn = t + gridDim.x;
    const bool has_next = tn < 64 * 16;
    const GTile tl{p.h(), D, p.wt_in0(), D, D, mt * 256, nt * 256}, nx{p.h(), D, p.wt_in0(), D, D, (tn & 63) * 256, (tn >> 6) * 256};
    WAVE_GEOM;
    const bool trans = nt == 12 && wn_ >= 2;
    if (trans) { f32x16 acc[2][4]; gemm_core<true>(tl, nx, has_next, false, pre, ra, rb, smem, acc);
      EpiVt e{p.vt0(), 2, 64, 3200, nullptr, 0}; e(acc, mt * 256 + wm_ * 128, nt * 256 + wn_ * 64, l32_, g_); }
    else { f32x16 acc[2][4]; gemm_core<false>(tl, nx, has_next, has_next, pre, ra, rb, smem, acc);
      EpiRowBf16 e{p.z(), LDZ0}; e(acc, mt * 256 + wm_ * 128, nt * 256 + wn_ * 64, l32_, g_); }
    pre = has_next && !trans;
  }
  for (int t = blockIdx.x; t < 128; t += gridDim.x) gemm_half_rowbf16(p.h(), D, p.wt_in0(), D, D, t * 128, 16 * 256, smem, p.z(), LDZ0);
}
DI void phase_conv(const Params& p) {
  for (int i = blockIdx.x * NTH + otid(); i < T * 128; i += gridDim.x * NTH) {
    const int tok = i >> 7, c = (i & 127) * 8, s = tok & 4095;
    float o[8];
#pragma unroll
    for (int e = 0; e < 8; ++e) o[e] = p.conv_b[c + e];
#pragma unroll
    for (int k = 0; k < 4; ++k) {
      const int ss = s - 3 + k;
      if (ss < 0) continue;
      const u32x4 v = *(const u32x4*)(p.z() + (size_t)(tok - 3 + k) * LDZ0 + c);
      const float* wk = p.conv_w + k * 1024 + c;
      o[0] += wk[0] * bflo(v.x); o[1] += wk[1] * bfhi(v.x); o[2] += wk[2] * bflo(v.y); o[3] += wk[3] * bfhi(v.y);
      o[4] += wk[4] * bflo(v.z); o[5] += wk[5] * bfhi(v.z); o[6] += wk[6] * bflo(v.w); o[7] += wk[7] * bfhi(v.w);
    }
    u32x4 w; w.x = pk_bf16(o[0], o[1]); w.y = pk_bf16(o[2], o[3]); w.z = pk_bf16(o[4], o[5]); w.w = pk_bf16(o[6], o[7]);
    *(u32x4*)(p.xc() + (size_t)tok * 1024 + c) = w;
  }
}
DI void phase_gates(const Params& p, char* smem) {
  u32x4 ra[4], rb[4]; bool pre = false;
  for (int t = blockIdx.x; t < 64 * 8; t += gridDim.x) {
    const int mt = t & 63, gi = t >> 6, tn = t + gridDim.x;
    const bool has_next = tn < 64 * 8;
    const GTile tl{p.xc() + gi * 128, 1024, p.wt_g(), 128, 128, mt * 256, gi * 256}, nx{p.xc() + (tn >> 6) * 128, 1024, p.wt_g(), 128, 128, (tn & 63) * 256, (tn >> 6) * 256};
    WAVE_GEOM;
    f32x16 acc[2][4];
    gemm_core<false>(tl, nx, has_next, has_next, pre, ra, rb, smem, acc);
    EpiGates e{&p, gi * 128 + wn_ * 32};
    e(acc, mt * 256 + wm_ * 128, gi * 256 + wn_ * 64, l32_, g_);
    pre = true;
  }
}
DI void phase_scan_local(const Params& p) {
  for (int i = blockIdx.x * NTH + otid(); i < NBATCH * 128 * 256; i += gridDim.x * NTH) {
    const int ch = (i & 255) * 4, c = (i >> 8) & 127, b = i >> 15;
    const size_t base = ((size_t)b * S + c * 32) * 1024 + ch;
    f32x4 A = {1.f, 1.f, 1.f, 1.f}, H = {0.f, 0.f, 0.f, 0.f};
#pragma unroll 1
    for (int t0 = 0; t0 < 32; t0 += 8) {
      f32x4 a[8], u[8];
#pragma unroll
      for (int j = 0; j < 8; ++j) { a[j] = *(const f32x4*)(p.av() + base + (size_t)(t0 + j) * 1024); u[j] = *(const f32x4*)(p.uv() + base + (size_t)(t0 + j) * 1024); }
#pragma unroll
      for (int j = 0; j < 8; ++j) { A *= a[j]; H = a[j] * H + u[j]; }
    }
    *(f32x4*)(p.carry() + (size_t)i * 4) = A; *(f32x4*)(p.carry() + (size_t)NBATCH * 128 * 1024 + (size_t)i * 4) = H;
  }
}
DI void phase_scan_fix(const Params& p) {
  for (int i = blockIdx.x * NTH + otid(); i < NBATCH * 128 * 256; i += gridDim.x * NTH) {
    const int ch = (i & 255) * 4, c = (i >> 8) & 127, b = i >> 15;
    f32x4 h = {0.f, 0.f, 0.f, 0.f};
    const float* cA = p.carry() + ((size_t)b * 128 * 256 + (i & 255)) * 4;
    const float* cH = cA + (size_t)NBATCH * 128 * 1024;
    int cc = 0;
#pragma unroll 1
    for (; cc + 8 <= c; cc += 8) {
      f32x4 a[8], u[8];
#pragma unroll
      for (int j = 0; j < 8; ++j) { a[j] = *(const f32x4*)(cA + (size_t)(cc + j) * 1024); u[j] = *(const f32x4*)(cH + (size_t)(cc + j) * 1024); }
#pragma unroll
      for (int j = 0; j < 8; ++j) h = a[j] * h + u[j];
    }
    for (; cc < c; ++cc) h = *(const f32x4*)(cA + (size_t)cc * 1024) * h + *(const f32x4*)(cH + (size_t)cc * 1024);
    const size_t tok0 = (size_t)b * S + c * 32;
#pragma unroll 1
    for (int t0 = 0; t0 < 32; t0 += 8) {
      f32x4 a[8], u[8]; u32x2 gt[8];
#pragma unroll
      for (int j = 0; j < 8; ++j) {
        const size_t tok = tok0 + t0 + j;
        a[j] = *(const f32x4*)(p.av() + tok * 1024 + ch); u[j] = *(const f32x4*)(p.uv() + tok * 1024 + ch);
        gt[j] = *(const u32x2*)(p.z() + tok * LDZ0 + 1024 + ch);
      }
#pragma unroll
      for (int j = 0; j < 8; ++j) {
        h = a[j] * h + u[j];
        store_bf4(p.h() + (tok0 + t0 + j) * D + ch, h[0] * siluf_(bflo(gt[j].x)), h[1] * siluf_(bfhi(gt[j].x)), h[2] * siluf_(bflo(gt[j].y)), h[3] * siluf_(bfhi(gt[j].y)));
      }
    }
  }
}
DI void phase_gemm_out(const Params& p, char* smem, const bf16_t* Wt, const float* R, float* O) {
  u32x4 ra[4], rb[4]; bool pre = false;
  for (int t = blockIdx.x; t < 64 * 8; t += gridDim.x) {
    const int mt = t & 63, nt = t >> 6, tn = t + gridDim.x;
    const bool has_next = tn < 64 * 8;
    const GTile tl{p.h(), D, Wt, D, D, mt * 256, nt * 256}, nx{p.h(), D, Wt, D, D, (tn & 63) * 256, (tn >> 6) * 256};
    WAVE_GEOM;
    f32x16 acc[2][4];
    gemm_core<false>(tl, nx, has_next, has_next, pre, ra, rb, smem, acc);
    const float* Rq = R; asm volatile("" : "+s"(Rq));
    EpiResid e{Rq, O};
    e(acc, mt * 256 + wm_ * 128, nt * 256 + wn_ * 64, l32_, g_);
    pre = true;
  }
}
DI int in1_nt(int t) { return (t >> 6) < 23 ? (t >> 6) : 25; }
DI void phase_gemm_in1(const Params& p, char* smem) {
  u32x4 ra[4], rb[4]; bool pre = false;
  for (int t = blockIdx.x; t < 64 * 24; t += gridDim.x) {
    const int mt = t & 63, nt = in1_nt(t), tn = t + gridDim.x;
    const bool has_next = tn < 64 * 24;
    const GTile tl{p.h(), D, p.wt_in1(), D, D, mt * 256, nt * 256}, nx{p.h(), D, p.wt_in1(), D, D, (tn & 63) * 256, in1_nt(tn) * 256};
    WAVE_GEOM;
    const bool trans = nt >= 17 && nt < 21;
    const int mbase = mt * 256 + wm_ * 128, nbase = nt * 256 + wn_ * 64;
    if (trans) { f32x16 acc[2][4]; gemm_core<true>(tl, nx, has_next, false, pre, ra, rb, smem, acc); EpiVt e{p.vtd(), 8, 128, 4352, nullptr, 0}; e(acc, mbase, nbase, l32_, g_); }
    else { f32x16 acc[2][4]; gemm_core<false>(tl, nx, has_next, has_next, pre, ra, rb, smem, acc);
      if (nt == 25) { EpiRopeK e{&p}; e(acc, mbase, nbase, l32_, g_); }
      else { EpiRowBf16 e{p.z(), LDZ1}; e(acc, mbase, nbase, l32_, g_); } }
    pre = has_next && !trans;
  }
  for (int t = blockIdx.x; t < 256; t += gridDim.x) gemm_half_rowbf16(p.h(), D, p.wt_in1(), D, D, (t & 127) * 128, (23 + (t >> 7)) * 256, smem, p.z(), LDZ1);
}
DI GTile up_tile(const Params& p, int t) {
  const int mt = t & 63, nt = t >> 6;
  if (nt < 6) return GTile{p.z(), LDZ1, p.wt_uq(), 768, 768, mt * 256, nt * 256};
  return GTile{p.z() + 768, LDZ1, p.wt_ukv(), 512, 512, mt * 256, (nt - 6) * 256};
}
DI void phase_up(const Params& p, char* smem) {
  float* rs = (float*)(smem + G_RSTD_OFF);
  u32x4 ra[4], rb[4]; bool pre = false;
  int rs_key = -1;
  for (int t = blockIdx.x; t < 64 * 14; t += gridDim.x) {
    const int mt = t & 63, nt = t >> 6, tn = t + gridDim.x;
    const bool has_next = tn < 64 * 14;
    const GTile tl = up_tile(p, t), nx = up_tile(p, has_next ? tn : t);
    WAVE_GEOM;
    const int mbase = mt * 256 + wm_ * 128;
    if (nt < 6) {
      f32x16 acc[2][4];
      if (rs_key != mt * 2) { row_rstd(p.z(), LDZ1, 768, mt * 256, rs); rs_key = mt * 2; }
      gemm_core<false>(tl, nx, has_next, has_next, pre, ra, rb, smem, acc);
      EpiQ e{&p, rs, mt * 256};
      e(acc, mbase, nt * 256 + wn_ * 64, l32_, g_);
    } else {
      const int head = nt - 6;
      const bool trans = wn_ >= 2;
      if (rs_key != mt * 2 + 1) { row_rstd(p.z() + 768, LDZ1, 512, mt * 256, rs); rs_key = mt * 2 + 1; }
      if (trans) { f32x16 acc[2][4]; gemm_core<true>(tl, nx, has_next, false, pre, ra, rb, smem, acc);
        EpiVt e{p.vt1(), 8, 128, head * 128 + 128, rs, mt * 256}; e(acc, mbase, head * 256 + wn_ * 64, l32_, g_); }
      else { f32x16 acc[2][4]; gemm_core<false>(tl, nx, has_next, has_next, pre, ra, rb, smem, acc);
        EpiKn e{&p, rs, mt * 256, head, head * 256}; e(acc, mbase, head * 256 + wn_ * 64, l32_, g_); }
    }
    pre = has_next && !(nt >= 6 && wn_ >= 2);
    __syncthreads();
  }
}

DI float diff_lambda(const Params& p) {
  float a = 0.f, b = 0.f;
  for (int i = 0; i < 64; ++i) { a += p.lq1[i] * p.lk1[i]; b += p.lq2[i] * p.lk2[i]; }
  return __expf(a) - __expf(b) + LAMBDA_INIT;
}

template <int DQK, int NMAP, int DV>
DI void attn_core(const bf16_t* __restrict__ q, int qs, const bf16_t* __restrict__ k0, int ks0, int w0, const bf16_t* __restrict__ k1, int ks1,
                  const bf16_t* __restrict__ vt, int q0, int kt_lo, int kt_hi, float sc, float m_init, float l_init, int window, char* smem,
                  f32x16 (&O)[NMAP][DV / 32], float (&lsum)[NMAP]) {
  constexpr int KW = DQK * NMAP, KS = KW + 8, CPR = KW / 8, NKC = 64 * CPR / NTH, NVC = DV * 8 / NTH, VS = 68, NDB = DV / 32, NKS = DQK / 16;
  constexpr int K_EL = 64 * KS, V_EL = DV * VS, ST_EL = K_EL + V_EL;
  static_assert(64 * CPR % NTH == 0 && DV * 8 % NTH == 0 && 2 * ST_EL * 2 <= G_BYTES, "attention tile shape");
  bf16_t* lds = (bf16_t*)smem;
  const int tid = otid(), lane = tid & 63, w = __builtin_amdgcn_readfirstlane(tid >> 6), l32 = lane & 31, g = lane >> 5;
  bf16x8 qf[NMAP][NKS];
  {
    const bf16_t* qrow = q + (size_t)(q0 + 32 * w + l32) * qs + 8 * g;
#pragma unroll
    for (int c = 0; c < NMAP; ++c)
#pragma unroll
      for (int ks = 0; ks < NKS; ++ks) qf[c][ks] = *(const bf16x8*)(qrow + c * DQK + 16 * ks);
  }
  float m[NMAP];
#pragma unroll
  for (int c = 0; c < NMAP; ++c) {
    m[c] = m_init; lsum[c] = g == 0 ? l_init : 0.f;
#pragma unroll
    for (int db = 0; db < NDB; ++db)
#pragma unroll
      for (int r = 0; r < 16; ++r) O[c][db][r] = 0.f;
  }
  u32x4 rk[NKC], rv[NVC];
#define ATTN_LOAD_K(KT)                                                                                            \
  {                                                                                                                \
    _Pragma("unroll") for (int i = 0; i < NKC; ++i) {                                                              \
      const int c = tid + NTH * i, key = c / CPR, col = (c % CPR) * 8;                                             \
      const size_t kg = (size_t)(KT) * 64 + key;                                                                   \
      const bf16_t* src = col < w0 ? k0 + kg * ks0 + col : k1 + kg * ks1 + (col - w0);                             \
      rk[i] = *(const u32x4*)src;                                                                                  \
    }                                                                                                              \
  }
#define ATTN_LOAD_V(KT)                                                                                            \
  {                                                                                                                \
    _Pragma("unroll") for (int i = 0; i < NVC; ++i) {                                                              \
      const int c = tid + NTH * i, dv = c >> 3, kc = c & 7;                                                        \
      rv[i] = *(const u32x4*)(vt + (size_t)dv * S + (KT) * 64 + kc * 8);                                           \
    }                                                                                                              \
  }
#define ATTN_LOAD(KT) { ATTN_LOAD_K(KT); ATTN_LOAD_V(KT); }
#define ATTN_STORE_K(ST)                                                                                           \
  {                                                                                                                \
    bf16_t* kb = lds + (ST) * ST_EL;                                                                               \
    _Pragma("unroll") for (int i = 0; i < NKC; ++i) {                                                              \
      const int c = tid + NTH * i, key = c / CPR, col = (c % CPR) * 8;                                             \
      *(u32x4*)(kb + key * KS + col) = rk[i];                                                                      \
    }                                                                                                              \
  }
#define ATTN_STORE_V(ST)                                                                                           \
  {                                                                                                                \
    bf16_t* vb = lds + (ST) * ST_EL + K_EL;                                                                        \
    _Pragma("unroll") for (int i = 0; i < NVC; ++i) {                                                              \
      const int c = tid + NTH * i, dv = c >> 3, kc = c & 7;                                                        \
      u32x2* d = (u32x2*)(vb + dv * VS + kc * 8);                                                                  \
      u32x2 lo = {rv[i].x, rv[i].y}, hi = {rv[i].z, rv[i].w};                                                      \
      d[0] = lo; d[1] = hi;                                                                                        \
    }                                                                                                              \
  }
#define ATTN_STORE(ST) { ATTN_STORE_K(ST); ATTN_STORE_V(ST); }
  ATTN_LOAD(kt_lo);
  ATTN_STORE(0);
  if (kt_lo < kt_hi) ATTN_LOAD(kt_lo + 1);
  const int qmin = q0 + 32 * w, qmax = qmin + 31, qpos = qmin + l32;
  for (int kt = kt_lo; kt <= kt_hi; ++kt) {
    const int cur = (kt - kt_lo) & 1;
    __syncthreads();
    if (kt < kt_hi) ATTN_STORE_K(cur ^ 1);
    if (kt + 1 < kt_hi) ATTN_LOAD_K(kt + 2);
    const int kmin0 = kt * 64;
    const bool act0 = kmin0 <= qmax && (window == 0 || kmin0 + 31 > qmin - window);
    const bool act1 = kmin0 + 32 <= qmax && (window == 0 || kmin0 + 63 > qmin - window);
    const bf16_t* kbase = lds + cur * ST_EL + l32 * KS + 8 * g;
    const bf16_t* vbase = lds + cur * ST_EL + K_EL + l32 * VS + 4 * g;
#pragma unroll
    for (int c = 0; c < NMAP; ++c) {
      f32x16 sa0, sa1;
#pragma unroll
      for (int r = 0; r < 16; ++r) { sa0[r] = 0.f; sa1[r] = 0.f; }
#define ATTN_QK(SA, KP)                                                                                            \
      {                                                                                                            \
        constexpr int PF = NKS < 4 ? NKS : 4;                                                                      \
        bf16x8 kf[PF];                                                                                             \
        _Pragma("unroll") for (int ks = 0; ks < PF; ++ks) kf[ks] = *(const bf16x8*)((KP) + 16 * ks);               \
        __builtin_amdgcn_sched_barrier(0);                                                                         \
        _Pragma("unroll") for (int ks = 0; ks < NKS; ++ks) {                                                       \
          SA = __builtin_amdgcn_mfma_f32_32x32x16_bf16(kf[ks % PF], qf[c][ks], SA, 0, 0, 0);                       \
          if (ks + PF < NKS) kf[ks % PF] = *(const bf16x8*)((KP) + 16 * (ks + PF));                                \
          __builtin_amdgcn_sched_barrier(0);                                                                       \
        }                                                                                                          \
      }
      if (act0) ATTN_QK(sa0, kbase + c * DQK);
      if (act1) ATTN_QK(sa1, kbase + 32 * KS + c * DQK);
#undef ATTN_QK
      if (c == NMAP - 1) {
        if (kt < kt_hi) ATTN_STORE_V(cur ^ 1);
        if (kt + 1 < kt_hi) ATTN_LOAD_V(kt + 2);
      }
#define ATTN_HALF(SA, HK)                                                                                          \
      {                                                                                                            \
        const int kmin = kmin0 + (HK) * 32, kmax = kmin + 31;                                                      \
        const bool need_mask = kmax > qmin || (window != 0 && kmin <= qmax - window);                              \
        if (need_mask) {     \
          asm volatile("" ::: "memory");                                                                           \
          const int lim = qpos - kmin - 4 * g;     \
          _Pragma("unroll") for (int r = 0; r < 16; ++r) {                                                         \
            const int ro = 8 * (r >> 2) + (r & 3);                                                                 \
            const bool vis = ro <= lim && (window == 0 || ro > lim - window);                                      \
            SA[r] = vis ? SA[r] : -1e30f;                                                                          \
          }                                                                                                        \
        }                                                                                                          \
        float mx = -1e30f;                                                                                         \
        _Pragma("unroll") for (int r = 0; r < 16; ++r) mx = fmaxf(mx, SA[r]);                                      \
          \
          \
          \
        float alpha = 1.f;                                                                                         \
        const bool resc = !__all(mx * sc - m[c] <= 8.f);                                                           \
        if (resc) {                                                                                                \
          auto sw = __builtin_amdgcn_permlane32_swap(__float_as_uint(mx), __float_as_uint(mx), false, false);      \
          const float mn = fmaxf(m[c], fmaxf(__uint_as_float(sw[0]), __uint_as_float(sw[1])) * sc);                \
          alpha = __builtin_amdgcn_exp2f(m[c] - mn); m[c] = mn;                                                    \
        }                                                                                                          \
        const float mcur = m[c];                                                                                   \
        float ps = 0.f;                                                                                            \
        _Pragma("unroll") for (int r = 0; r < 16; ++r) { SA[r] = __builtin_amdgcn_exp2f(__builtin_fmaf(SA[r], sc, -mcur)); ps += SA[r]; } \
        lsum[c] = lsum[c] * alpha + ps;                                                                            \
        bf16x8 pf[2];                                                                                              \
        _Pragma("unroll") for (int s2 = 0; s2 < 2; ++s2) {                                                         \
          u32x4 pk;                                                                                                \
          pk.x = pk_bf16(SA[8 * s2 + 0], SA[8 * s2 + 1]); pk.y = pk_bf16(SA[8 * s2 + 2], SA[8 * s2 + 3]);          \
          pk.z = pk_bf16(SA[8 * s2 + 4], SA[8 * s2 + 5]); pk.w = pk_bf16(SA[8 * s2 + 6], SA[8 * s2 + 7]);          \
          pf[s2] = __builtin_bit_cast(bf16x8, pk);                                                                 \
        }                                                                                                          \
        if (resc) {     \
          asm volatile("" ::: "memory");                                                                           \
          _Pragma("unroll") for (int db = 0; db < NDB; ++db)                                                       \
            _Pragma("unroll") for (int r = 0; r < 16; ++r) O[c][db][r] *= alpha;                                   \
        }                                                                                                          \
        const bf16_t* vb = vbase + (HK) * 32;                                                                      \
        u32x4 vf[4];                                                                                               \
        _Pragma("unroll") for (int i = 0; i < 4; ++i) {                                                            \
          const u32x2 lo = *(const u32x2*)(vb + (i >> 1) * 32 * VS + 16 * (i & 1));                                \
          const u32x2 hi = *(const u32x2*)(vb + (i >> 1) * 32 * VS + 16 * (i & 1) + 8);                            \
          vf[i] = (u32x4){lo.x, lo.y, hi.x, hi.y};                                                                 \
        }                                                                                                          \
        __builtin_amdgcn_sched_barrier(0);                                                                         \
        _Pragma("unroll") for (int i = 0; i < 2 * NDB; ++i) {                                                      \
          O[c][i >> 1] = __builtin_amdgcn_mfma_f32_32x32x16_bf16(__builtin_bit_cast(bf16x8, vf[i & 3]), pf[i & 1], O[c][i >> 1], 0, 0, 0); \
          if (i + 4 < 2 * NDB) {                                                                                   \
            const int n = i + 4;                                                                                   \
            const u32x2 lo = *(const u32x2*)(vb + (n >> 1) * 32 * VS + 16 * (n & 1));                              \
            const u32x2 hi = *(const u32x2*)(vb + (n >> 1) * 32 * VS + 16 * (n & 1) + 8);                          \
            vf[i & 3] = (u32x4){lo.x, lo.y, hi.x, hi.y};                                                           \
          }                                                                                                        \
          __builtin_amdgcn_sched_barrier(0);                                                                       \
        }                                                                                                          \
      }
      if (act0) ATTN_HALF(sa0, 0);
      if (act1) ATTN_HALF(sa1, 1);
#undef ATTN_HALF
    }
  }
  __syncthreads();
#undef ATTN_LOAD
#undef ATTN_STORE
#undef ATTN_LOAD_K
#undef ATTN_LOAD_V
#undef ATTN_STORE_K
#undef ATTN_STORE_V
#pragma unroll
  for (int c = 0; c < NMAP; ++c) lsum[c] += __shfl_xor(lsum[c], 32);
}

DI void attn_store_gated(bf16_t* yrow, const bf16_t* grow, const f32x16& o, float inv, int db, int g) {
#pragma unroll
  for (int j = 0; j < 4; ++j) {
    const int dv = 32 * db + 8 * j + 4 * g;
    const u32x2 gr = *(const u32x2*)(grow + dv);
    store_bf4(yrow + dv, o[4 * j] * inv * siluf_(bflo(gr.x)), o[4 * j + 1] * inv * siluf_(bfhi(gr.x)), o[4 * j + 2] * inv * siluf_(bflo(gr.y)), o[4 * j + 3] * inv * siluf_(bfhi(gr.y)));
  }
}

DI void swa_item(const Params& p, int it, char* smem) {
  const int qh = it & 15, qt = (it >> 4) & 15, b = it >> 8, kvh = qh >> 3;
  const int tid_ = otid(), lane = tid_ & 63, w = tid_ >> 6, l32 = lane & 31, g = lane >> 5;
  f32x16 O[1][2]; float ls[1];
  const bf16_t* zb = p.z() + (size_t)b * S * LDZ0;
  attn_core<64, 1, 64>(zb + 2048 + qh * 64, LDZ0, zb + 3072 + kvh * 64, LDZ0, 64, nullptr, 0, p.vt0() + (size_t)(b * 2 + kvh) * 64 * S,
                       qt * 256, max(0, qt * 4 - 2), qt * 4 + 3, 0.125f * LOG2E, p.sinks[qh] * LOG2E, 1.f, 128, smem, O, ls);
  const size_t tok = (size_t)b * S + qt * 256 + 32 * w + l32;
  const float inv = 1.f / ls[0];
#pragma unroll
  for (int db = 0; db < 2; ++db) attn_store_gated(p.h() + tok * D + 1024 + qh * 64, p.z() + tok * LDZ0 + 3328 + qh * 64, O[0][db], inv, db, g);
}
DI void mla_item(const Params& p, int b, int hh, int qt, char* smem) {
  const int tid_ = otid(), lane = tid_ & 63, w = tid_ >> 6, l32 = lane & 31, g = lane >> 5;
  f32x16 O[1][4]; float ls[1];
  attn_core<192, 1, 128>(p.q1() + (size_t)b * S * 1536 + hh * 192, 1536, p.kn() + (size_t)b * S * 1024 + hh * 128, 1024, 128, p.kr() + (size_t)b * S * 64, 64,
                         p.vt1() + (size_t)(b * 8 + hh) * 128 * S, qt * 256, 0, qt * 4 + 3, 0.07216878364870322f * LOG2E, -1e30f, 0.f, 0, smem, O, ls);
  const size_t tok = (size_t)b * S + qt * 256 + 32 * w + l32;
  const float inv = 1.f / ls[0];
#pragma unroll
  for (int db = 0; db < 4; ++db) attn_store_gated(p.h() + tok * D + hh * 128, p.z() + tok * LDZ1 + 1280 + hh * 128, O[0][db], inv, db, g);
}
DI void diff_item(const Params& p, int b, int hh, int qt, float lam, char* smem) {
  const int tid_ = otid(), lane = tid_ & 63, w = tid_ >> 6, l32 = lane & 31, g = lane >> 5;
  f32x16 O[1][4]; float ls[1];
  const bf16_t* zb = p.z() + (size_t)b * S * LDZ1;
  const bf16_t* vt = p.vtd() + (size_t)(b * 8 + hh) * 128 * S;
  f32x4* park = (f32x4*)(p.park() + ((size_t)blockIdx.x * NTH + tid_) * 64);
  attn_core<64, 1, 128>(zb + 2304 + hh * 128, LDZ1, zb + 3328 + hh * 128, LDZ1, 64, nullptr, 0, vt, qt * 256, 0, qt * 4 + 3, 0.125f * LOG2E, -1e30f, 0.f, 0, smem, O, ls);
  {
    const float i0 = 1.f / ls[0];
#pragma unroll
    for (int db = 0; db < 4; ++db)
#pragma unroll
      for (int j = 0; j < 4; ++j) { f32x4 v = {O[0][db][4 * j] * i0, O[0][db][4 * j + 1] * i0, O[0][db][4 * j + 2] * i0, O[0][db][4 * j + 3] * i0}; park[db * 4 + j] = v; }
  }
  attn_core<64, 1, 128>(zb + 2304 + hh * 128 + 64, LDZ1, zb + 3328 + hh * 128 + 64, LDZ1, 64, nullptr, 0, vt, qt * 256, 0, qt * 4 + 3, 0.125f * LOG2E, -1e30f, 0.f, 0, smem, O, ls);
  const size_t tok = (size_t)b * S + qt * 256 + 32 * w + l32;
  const float i1 = lam / ls[0];
  float ss = 0.f;
#pragma unroll
  for (int db = 0; db < 4; ++db)
#pragma unroll
    for (int j = 0; j < 4; ++j) {
      const f32x4 pv = park[db * 4 + j];
#pragma unroll
      for (int i = 0; i < 4; ++i) { const float od = pv[i] - O[0][db][4 * j + i] * i1; O[0][db][4 * j + i] = od; ss += od * od; }
    }
  ss += __shfl_xor(ss, 32);
  const float rstd = rsqrtf(ss * (1.f / 128.f) + EPS) * (1.f - LAMBDA_INIT);
  const float* slp = p.subln; asm volatile("" : "+s"(slp));
  bf16_t* yrow = p.h() + tok * D + 1024 + hh * 128;
  const bf16_t* grow = p.z() + tok * LDZ1 + 5376 + hh * 128;
#pragma unroll
  for (int db = 0; db < 4; ++db)
#pragma unroll
    for (int j = 0; j < 4; ++j) {
      const int dv = 32 * db + 8 * j + 4 * g;
      const u32x2 gr = *(const u32x2*)(grow + dv);
      const f32x4 sl = *(const f32x4*)(slp + dv);
      store_bf4(yrow + dv, O[0][db][4 * j] * rstd * sl[0] * siluf_(bflo(gr.x)), O[0][db][4 * j + 1] * rstd * sl[1] * siluf_(bfhi(gr.x)),
                O[0][db][4 * j + 2] * rstd * sl[2] * siluf_(bflo(gr.y)), O[0][db][4 * j + 3] * rstd * sl[3] * siluf_(bfhi(gr.y)));
    }
}
DI void phase_swa(const Params& p, char* smem) {
  for (int it = blockIdx.x; it < NBATCH * 16 * 16; it += gridDim.x) swa_item(p, it, smem);
}
DI void phase_attn1(const Params& p, char* smem) {
  const int G = gridDim.x;
  for (int round = 0; round * G < 512; ++round) {
    const int j = (round & 1) ? (G - 1 - (int)blockIdx.x) : (int)blockIdx.x;
    const int t = round * G + j;
    if (t >= 512) continue;
    const int qt = 15 - (t >> 5), bh = t & 31;
    mla_item(p, bh >> 3, bh & 7, qt, smem);
  }
  const float lam = diff_lambda(p);
  for (int round = 0; round * G < 512; ++round) {
    const int j = (round & 1) ? (G - 1 - (int)blockIdx.x) : (int)blockIdx.x;
    const int t = round * G + j;
    if (t >= 512) continue;
    const int qt = 15 - (t >> 5), bh = t & 31;
    diff_item(p, bh >> 3, bh & 7, qt, lam, smem);
  }
}

#define XB_TMO      128
#define XB_XCNT(j)  (256  + 64 * (j))
#define XB_XSUB(j)  (1280 + 64 * (j))
#define XB_XGEN(j)  (2304 + 64 * (j))
#define XB_TOP      3328
#define XB_TOPGEN   3392
#define XCD_BAR_WORDS 3456
#define XB_SPIN_CAP (1u << 18)
#define LAS __attribute__((address_space(3)))

__device__ __forceinline__ unsigned xb_ld(unsigned* p)              { return __hip_atomic_load(p, __ATOMIC_RELAXED, __HIP_MEMORY_SCOPE_AGENT); }
__device__ __forceinline__ unsigned xb_add(unsigned* p, unsigned v) { return __hip_atomic_fetch_add(p, v, __ATOMIC_RELAXED, __HIP_MEMORY_SCOPE_AGENT); }
__device__ __forceinline__ unsigned xb_xcc_id() { return (unsigned)__builtin_amdgcn_s_getreg((3 << 11) | 20) & 0xFu; }
#define XB_SPIN(cond, bar) do { unsigned _sp = 0; while (cond) { __builtin_amdgcn_s_sleep(1); \
    if ((++_sp & 255u) == 0u) { if (xb_ld(&(bar)[XB_TMO])) break; if (_sp > XB_SPIN_CAP) { atomicAdd(&(bar)[XB_TMO], 1u); break; } } } } while (0)

struct XcdBarrier {
    unsigned* bar; unsigned x;
    volatile LAS unsigned* st;
};

__device__ __forceinline__ XcdBarrier xcd_barrier_post(unsigned* bar, volatile LAS unsigned* st) {
    XcdBarrier b; b.bar = bar; b.x = xb_xcc_id(); b.st = st;
    if (threadIdx.x == 0) (void)xb_add(&bar[XB_XCNT(b.x)], 1u);
    return b;
}
__device__ __forceinline__ void xcd_barrier_complete(unsigned* bar, unsigned x, unsigned& nloc, unsigned& nx) {
    const unsigned G = gridDim.x * gridDim.y * gridDim.z;
    unsigned sum, cnt, mine, sp = 0u;
    for (;;) {
        sum = 0u; cnt = 0u; mine = 0u;
#pragma unroll
        for (unsigned j = 0; j < 16; ++j) { const unsigned c = xb_ld(&bar[XB_XCNT(j)]); sum += c; cnt += (c > 0u) ? 1u : 0u; mine = (j == x) ? c : mine; }
        if (sum == G) break;
        __builtin_amdgcn_s_sleep(1);
        if ((++sp & 255u) == 0u) { if (xb_ld(&bar[XB_TMO])) break; if (sp > XB_SPIN_CAP) { atomicAdd(&bar[XB_TMO], 1u); break; } }
    }
    nloc = mine > 0u ? mine : 1u; nx = cnt > 0u ? cnt : 1u;
}

__device__ __forceinline__ void xcd_barrier(const XcdBarrier& b) {
    asm volatile("s_waitcnt vmcnt(0)" ::: "memory");
    __syncthreads();
    if (threadIdx.x == 0) {
        unsigned* bar = b.bar;
        __builtin_amdgcn_s_waitcnt(0);
        unsigned nloc = b.st[0], nx = b.st[1];
        if (nloc == 0u) { xcd_barrier_complete(bar, b.x, nloc, nx); b.st[0] = nloc; b.st[1] = nx; }
        const unsigned old = xb_add(&bar[XB_XSUB(b.x)], 1u);
        const unsigned gen = old / nloc;
        if (old + 1u == (gen + 1u) * nloc) {
            __builtin_amdgcn_fence(__ATOMIC_RELEASE, "agent");
            asm volatile("s_waitcnt vmcnt(0)" ::: "memory");
            const unsigned og = xb_add(&bar[XB_TOP], 1u);
            const unsigned tg = og / nx;
            if (og + 1u == (tg + 1u) * nx) xb_add(&bar[XB_TOPGEN], 1u);
            else XB_SPIN(xb_ld(&bar[XB_TOPGEN]) == tg, bar);
            __builtin_amdgcn_fence(__ATOMIC_ACQUIRE, "agent");
            xb_add(&bar[XB_XGEN(b.x)], 1u);
            asm volatile("s_waitcnt vmcnt(0)" ::: "memory");
        } else {
            XB_SPIN(xb_ld(&bar[XB_XGEN(b.x)]) == gen, bar);
            __builtin_amdgcn_fence(__ATOMIC_ACQUIRE, "agent");
            asm volatile("s_waitcnt vmcnt(0)" ::: "memory");
        }
    }
    __syncthreads();
}

DI void gbar(unsigned* ctr, unsigned& epoch) {
  asm volatile("s_waitcnt vmcnt(0)" ::: "memory");
  __syncthreads();
  if (threadIdx.x == 0) {
    __builtin_amdgcn_fence(__ATOMIC_RELEASE, "agent");
    asm volatile("s_waitcnt vmcnt(0)" ::: "memory");
    __hip_atomic_fetch_add(ctr, 1u, __ATOMIC_RELAXED, __HIP_MEMORY_SCOPE_AGENT);
    const unsigned target = (epoch + 1u) * gridDim.x;
    while (__hip_atomic_load(ctr, __ATOMIC_RELAXED, __HIP_MEMORY_SCOPE_AGENT) < target) __builtin_amdgcn_s_sleep(2);
    __builtin_amdgcn_fence(__ATOMIC_ACQUIRE, "agent");
    asm volatile("s_waitcnt vmcnt(0)" ::: "memory");
  }
  __syncthreads();
  ++epoch;
}

constexpr int NPHASE = 13;
template <int PH>
DI void run_phase(const Params& p, char* smem) {
  if (PH == 0) { prep_weights(p, smem); rmsnorm_phase(p.x, p.norm_gains, p.h(), nullptr); }
  else if (PH == 1) phase_gemm_in0(p, smem);
  else if (PH == 2) { phase_conv(p); phase_swa(p, smem); }
  else if (PH == 3) phase_gates(p, smem);
  else if (PH == 4) phase_scan_local(p);
  else if (PH == 5) phase_scan_fix(p);
  else if (PH == 6) phase_gemm_out(p, smem, p.wt_out0(), p.x, p.out);
  else if (PH == 7) rmsnorm_phase(p.out, p.norm_gains + D, p.h(), nullptr);
  else if (PH == 8) phase_gemm_in1(p, smem);
  else if (PH == 9) phase_up(p, smem);
  else if (PH == 10) phase_attn1(p, smem);
  else if (PH == 11) phase_gemm_out(p, smem, p.wt_out1(), p.out, p.out);
  else if (PH == 12) rmsnorm_phase(p.out, p.final_gain, nullptr, p.out);
}

#if !MEGA
template <int PH>
__global__ void __launch_bounds__(NTH, 2) phase_kernel(Params p) {
  extern __shared__ __attribute__((aligned(16))) char smem[];
  run_phase<PH>(p, smem);
}

#else
__global__ void __launch_bounds__(NTH, 2) mega_kernel(Params p) {
  extern __shared__ __attribute__((aligned(16))) char smem[];
  cg::grid_group grid = cg::this_grid();
  __shared__ __attribute__((aligned(16))) unsigned xb_st[4];
  if (threadIdx.x < 4) xb_st[threadIdx.x] = 0u;
  __syncthreads();
  const XcdBarrier xb = xcd_barrier_post(p.bar(), (volatile LAS unsigned*)xb_st);
  unsigned epoch = 0;
  run_phase<0>(p, smem); grid.sync();
  run_phase<1>(p, smem); xcd_barrier(xb);
  run_phase<2>(p, smem); xcd_barrier(xb);
  run_phase<3>(p, smem); xcd_barrier(xb);
  run_phase<4>(p, smem); xcd_barrier(xb);
  run_phase<5>(p, smem); xcd_barrier(xb);
  run_phase<6>(p, smem); xcd_barrier(xb);
  run_phase<7>(p, smem); xcd_barrier(xb);
  run_phase<8>(p, smem); xcd_barrier(xb);
  run_phase<9>(p, smem); xcd_barrier(xb);
  run_phase<10>(p, smem); xcd_barrier(xb);
  run_phase<11>(p, smem); xcd_barrier(xb);
  run_phase<12>(p, smem);
}

#endif
#if !MEGA
template <int PH> static void launch_phase(const Params& p, hipStream_t st) {
  (void)hipFuncSetAttribute((const void*)phase_kernel<PH>, hipFuncAttributeMaxDynamicSharedMemorySize, SMEM_BYTES);
  hipLaunchKernelGGL(phase_kernel<PH>, dim3(256), dim3(NTH), SMEM_BYTES, st, p);
}
#endif

extern "C" void kernel_launch(void* const* d_in, const int* in_sizes, int n_in, void* d_out, int out_size, void* d_ws, size_t ws_size, hipStream_t stream) {
  Params p{};
  const float* const* in = (const float* const*)d_in;
  p.x = in[0]; p.norm_gains = in[1]; p.final_gain = in[2];
  p.w_in0 = in[3]; p.conv_w = in[4]; p.conv_b = in[5]; p.gx_w = in[6]; p.gx_b = in[7]; p.ga_w = in[8]; p.ga_b = in[9]; p.lru_lambda = in[10]; p.sinks = in[11]; p.w_out0 = in[12];
  p.w_in1 = in[13]; p.q_norm = in[14]; p.w_uq = in[15]; p.kv_norm = in[16]; p.w_ukv = in[17]; p.lq1 = in[18]; p.lk1 = in[19]; p.lq2 = in[20]; p.lk2 = in[21]; p.subln = in[22]; p.w_out1 = in[23];
  p.out = (float*)d_out;
  p.ws = (char*)d_ws;
  const size_t off = WS_NEEDED;
  if (off > ws_size) { fprintf(stderr, "workspace too small: need %zu have %zu\n", off, ws_size); return; }
#if MEGA
  static int grid_blocks = 0;
  if (!grid_blocks) {
    int dev = 0, cus = 0, per_cu = 0;
    (void)hipGetDevice(&dev);
    (void)hipDeviceGetAttribute(&cus, hipDeviceAttributeMultiprocessorCount, dev);
    (void)hipFuncSetAttribute((const void*)mega_kernel, hipFuncAttributeMaxDynamicSharedMemorySize, SMEM_BYTES);
    (void)hipOccupancyMaxActiveBlocksPerMultiprocessor(&per_cu, mega_kernel, NTH, SMEM_BYTES);
    if (per_cu > 1) per_cu = 1;
    grid_blocks = cus * per_cu;
  }
  (void)hipMemsetAsync(p.ws + OFF_BAR, 0, XCD_BAR_WORDS * 4, stream);
  void* args[] = {&p};
  hipError_t e = hipLaunchCooperativeKernel((void*)mega_kernel, dim3(grid_blocks), dim3(NTH), args, SMEM_BYTES, stream);
  if (e != hipSuccess) fprintf(stderr, "cooperative launch failed: %s (grid %d)\n", hipGetErrorString(e), grid_blocks);
#else
  launch_phase<0>(p, stream); launch_phase<1>(p, stream); launch_phase<2>(p, stream); launch_phase<3>(p, stream);
  launch_phase<4>(p, stream); launch_phase<5>(p, stream); launch_phase<6>(p, stream); launch_phase<7>(p, stream);
  launch_phase<8>(p, stream); launch_phase<9>(p, stream); launch_phase<10>(p, stream); launch_phase<11>(p, stream);
  launch_phase<12>(p, stream);
#endif
}
```
